# Optimizing an MI355X kernel written in HIP

```python
import jax, jax.numpy as jnp
from jax import lax
import numpy as np

D_MODEL = 1024
BATCH = 8
SEQ = 4096
DEPTH = 4

N_A_LAYERS = DEPTH // 2
N_B_LAYERS = DEPTH - N_A_LAYERS
CHUNK = 128
GMLP_WIDTH = 2 * D_MODEL
GMLP_GROUPS = 8
N_HEADS = 16
HEAD_DIM = D_MODEL // N_HEADS
D_FF = 4 * D_MODEL
Q_BLOCK = 128
MOD_INIT = 0.5
EPS = 1e-6

kernel_name = "yoco_gmlp_stickbreaking_hybrid"


def _rmsnorm(x, g):
    xf = x.astype(jnp.float32)
    y = xf * lax.rsqrt(jnp.mean(xf * xf, axis=-1, keepdims=True) + EPS)
    return (y * g.astype(jnp.float32)).astype(x.dtype)


def _modulate(h, shift, scale):
    return h * (1 + scale[:, None, :]) + shift[:, None, :]


def _gmlp_mixer(h, w_in, v_norm_g, w_s, b_s, w_out):
    B, S, _ = h.shape
    uv = jax.nn.gelu(h @ w_in, approximate=False)
    u, v = jnp.split(uv, 2, axis=-1)
    v = _rmsnorm(v, v_norm_g)
    n_chunks = S // CHUNK
    v = v.reshape(B, n_chunks, CHUNK, GMLP_GROUPS, GMLP_WIDTH // GMLP_GROUPS)
    w_causal = jnp.tril(w_s)
    z = jnp.einsum("gts,bnsgc->bntgc", w_causal, v) + b_s.T[None, None, :, :, None]
    z = z.reshape(B, S, GMLP_WIDTH)
    return (u * z) @ w_out


def _stick_breaking(q, k, v):
    S = q.shape[2]
    scale = HEAD_DIM ** -0.5
    outs = []
    for blk in range(S // Q_BLOCK):
        t0 = blk * Q_BLOCK
        n_keys = t0 + Q_BLOCK
        qb = q[:, :, t0:n_keys]
        kb = k[:, :, :n_keys]
        vb = v[:, :, :n_keys]
        z = jnp.einsum("bhtd,bhsd->bhts", qb, kb,
                       preferred_element_type=jnp.float32) * scale
        t_pos = t0 + jnp.arange(Q_BLOCK)[:, None]
        s_pos = jnp.arange(n_keys)[None, :]
        causal = s_pos < t_pos
        log_beta = jax.nn.log_sigmoid(z)
        log_keep = jnp.where(causal, jax.nn.log_sigmoid(-z), 0.0)
        between = lax.cumsum(log_keep, axis=3, reverse=True) - log_keep
        weights = jnp.where(causal, jnp.exp(log_beta + between), 0.0)
        outs.append(jnp.einsum("bhts,bhsd->bhtd", weights.astype(vb.dtype), vb))
    return jnp.concatenate(outs, axis=2)


def setup_inputs(seed: int = 0) -> dict:
    key = jax.random.key(seed)
    ks = jax.random.split(key, 20)
    D = D_MODEL
    W = GMLP_WIDTH

    def nrm(k, shape, s):
        return jax.random.normal(k, shape, jnp.float32) * s

    return {
        "x": nrm(ks[0], (BATCH, SEQ, D), 1.0),
        "c": nrm(ks[1], (BATCH, D), 1.0),
        "mod_w": nrm(ks[2], (DEPTH, D, 6 * D), MOD_INIT * D ** -0.5),
        "mod_b": nrm(ks[3], (DEPTH, 6 * D), 0.02),
        "norm_g": 1.0 + nrm(ks[4], (DEPTH, 2, D), 0.02),
        "mlp_w_up": nrm(ks[5], (DEPTH, D, D_FF), D ** -0.5),
        "mlp_w_down": nrm(ks[6], (DEPTH, D_FF, D), D_FF ** -0.5),
        "a_w_in": nrm(ks[7], (N_A_LAYERS, D, 2 * W), D ** -0.5),
        "a_v_norm_g": 1.0 + nrm(ks[8], (N_A_LAYERS, W), 0.02),
        "a_w_spatial": nrm(ks[9], (N_A_LAYERS, GMLP_GROUPS, CHUNK, CHUNK), CHUNK ** -0.5),
        "a_b_spatial": 1.0 + nrm(ks[10], (N_A_LAYERS, GMLP_GROUPS, CHUNK), 0.02),
        "a_w_out": nrm(ks[11], (N_A_LAYERS, W, D), W ** -0.5),
        "kv_mod_w": nrm(ks[12], (D, 2 * D), MOD_INIT * D ** -0.5),
        "kv_mod_b": nrm(ks[13], (2 * D,), 0.02),
        "kv_norm_g": 1.0 + nrm(ks[14], (D,), 0.02),
        "kv_w": nrm(ks[15], (D, 2 * D), D ** -0.5),
        "k_norm_g": 1.0 + nrm(ks[16], (HEAD_DIM,), 0.02),
        "b_w_q": nrm(ks[17], (N_B_LAYERS, D, D), D ** -0.5),
        "q_norm_g": 1.0 + nrm(ks[18], (N_B_LAYERS, HEAD_DIM), 0.02),
        "b_w_out": nrm(ks[19], (N_B_LAYERS, D, D), D ** -0.5),
    }


def reference(x, c, mod_w, mod_b, norm_g, mlp_w_up, mlp_w_down, a_w_in, a_v_norm_g,
              a_w_spatial, a_b_spatial, a_w_out, kv_mod_w, kv_mod_b, kv_norm_g, kv_w,
              k_norm_g, b_w_q, q_norm_g, b_w_out):
    B, S, D = x.shape
    k_shared = None
    v_shared = None
    for layer in range(DEPTH):
        mod = c @ mod_w[layer] + mod_b[layer]
        sh1, sc1, g1, sh2, sc2, g2 = jnp.split(mod, 6, axis=-1)
        h = _modulate(_rmsnorm(x, norm_g[layer, 0]), sh1, sc1)
        if layer < N_A_LAYERS:
            i = layer
            y = _gmlp_mixer(h, a_w_in[i], a_v_norm_g[i], a_w_spatial[i],
                            a_b_spatial[i], a_w_out[i])
        else:
            j = layer - N_A_LAYERS
            q = (h @ b_w_q[j]).reshape(B, S, N_HEADS, HEAD_DIM)
            q = _rmsnorm(q, q_norm_g[j]).transpose(0, 2, 1, 3)
            o = _stick_breaking(q, k_shared, v_shared)
            y = o.transpose(0, 2, 1, 3).reshape(B, S, D) @ b_w_out[j]
        x = x + g1[:, None, :] * y
        h = _modulate(_rmsnorm(x, norm_g[layer, 1]), sh2, sc2)
        y = jnp.square(jax.nn.relu(h @ mlp_w_up[layer])) @ mlp_w_down[layer]
        x = x + g2[:, None, :] * y
        if layer == N_A_LAYERS - 1:
            kv_shift, kv_scale = jnp.split(c @ kv_mod_w + kv_mod_b, 2, axis=-1)
            hk = _modulate(_rmsnorm(x, kv_norm_g), kv_shift, kv_scale)
            k_all, v_all = jnp.split(hk @ kv_w, 2, axis=-1)
            k_shared = _rmsnorm(k_all.reshape(B, S, N_HEADS, HEAD_DIM),
                                k_norm_g).transpose(0, 2, 1, 3)
            v_shared = v_all.reshape(B, S, N_HEADS, HEAD_DIM).transpose(0, 2, 1, 3)
    return x
```

```cpp
#include <hip/hip_runtime.h>
#include <hip/hip_cooperative_groups.h>
#include <cstdio>
#include <cstdint>
namespace cg = cooperative_groups;

#define DI __device__ __forceinline__
#define LAS __attribute__((address_space(3)))
#define GAS __attribute__((address_space(1)))
typedef unsigned short bf16_t;
typedef short bf16x8 __attribute__((ext_vector_type(8)));
typedef float f32x4 __attribute__((ext_vector_type(4)));
typedef float f32x2 __attribute__((ext_vector_type(2)));
typedef float f32x16 __attribute__((ext_vector_type(16)));
typedef unsigned u32x4 __attribute__((ext_vector_type(4)));
typedef unsigned u32x2 __attribute__((ext_vector_type(2)));
typedef __bf16 bf16x2_t __attribute__((ext_vector_type(2)));

constexpr int DM = 1024, BATCH = 8, SEQ = 4096, MTOK = BATCH * SEQ, DFF = 4096, GW = 2048, NH = 16, HD = 64;
constexpr float EPS = 1e-6f;
constexpr float LOG2E = 1.4426950408889634f;
constexpr int MODS = 6 * DM;
constexpr int HP = DFF + 64, UVP = 2 * GW + 64;
constexpr int VTP = MTOK + 64;
constexpr float CARRY_STOP = -48.0f;

constexpr size_t MiB = 1u << 20;
constexpr size_t WS_MOD = 1 * MiB;
constexpr size_t WS_SSQ = 2 * MiB;
constexpr size_t WS_UP23 = 8 * MiB, WS_DN23 = 24 * MiB, WS_WQ = 40 * MiB, WS_WBO = 44 * MiB;
constexpr size_t WS_XN = 48 * MiB;
constexpr size_t WS_UP01 = 112 * MiB, WS_DN01 = 128 * MiB, WS_WIN = 144 * MiB, WS_WAO = 160 * MiB;
constexpr size_t WS_WKV = 500 * MiB;
constexpr size_t WS_UV = 172 * MiB;
constexpr size_t WS_H = 240 * MiB;
constexpr size_t WS_KR = 240 * MiB, WS_VT = 304 * MiB;
constexpr size_t WS_KF = 112 * MiB, WS_VF = 176 * MiB;
constexpr size_t WS_Q = 240 * MiB, WS_O = 304 * MiB, WS_END = 504 * MiB;
constexpr size_t WS_XN2 = 400 * MiB;
__host__ __device__ constexpr size_t ws_up(int l) { return l < 2 ? WS_UP01 + (size_t)l * 8 * MiB : WS_UP23 + (size_t)(l - 2) * 8 * MiB; }
__host__ __device__ constexpr size_t ws_dn(int l) { return l < 2 ? WS_DN01 + (size_t)l * 8 * MiB : WS_DN23 + (size_t)(l - 2) * 8 * MiB; }

#ifndef WT_AUX
#define WT_AUX 0
#endif
#ifndef STAGGER
#define STAGGER 0
#endif
#ifndef REP_SYNC
#define REP_SYNC 1
#endif
#ifndef REP_NORM
#define REP_NORM 1
#endif
#ifndef REP_ATTN
#define REP_ATTN 1
#endif
#ifndef REP_P0
#define REP_P0 1
#endif
#ifndef REP_SPAT
#define REP_SPAT 1
#endif
#ifndef REP_GRES
#define REP_GRES 1
#endif
#ifndef REP_G1
#define REP_G1 1
#endif
#ifndef REP_UP
#define REP_UP 1
#endif
#ifndef ATTN_SKEW
#define ATTN_SKEW 0
#endif
#ifndef REP_GACT
#define REP_GACT 1
#endif
constexpr int LDS_BYTES = 147456;
constexpr int NTHREADS = 512;

DI unsigned cvtpk(float lo, float hi) { f32x2 v = {lo, hi}; bf16x2_t b = __builtin_convertvector(v, bf16x2_t); return __builtin_bit_cast(unsigned, b); }
DI float bflo(unsigned u) { return __uint_as_float(u << 16); }
DI float bfhi(unsigned u) { return __uint_as_float(u & 0xffff0000u); }
DI float wave_sum(float v) {
#pragma unroll
    for (int o = 1; o < 64; o <<= 1) v += __shfl_xor(v, o);
    return v;
}

namespace pg8 {
constexpr int BM = 256, BK = 64, HALF = 128, HTB = HALF * BK * 2, STAGE_BYTES = 8 * HTB, NXCD = 8, WGM = 8;
__host__ __device__ __forceinline__ int lds_byte(int r, int c) { const int st = (r >> 4) * 2 + (c >> 5), rr = r & 15, cc = c & 31, ob = rr * 64 + cc * 2; return st * 1024 + (ob ^ (((ob >> 9) & 1) << 5)); }
__host__ __device__ __forceinline__ void stage_rc(int b, int& R, int& C) { const int st = b / 1024, sb = b % 1024, swz = sb ^ (((sb >> 9) & 1) << 5); R = (st >> 1) * 16 + swz / 64; C = (st & 1) * 32 + (swz % 64) / 2; }
__host__ __device__ __forceinline__ int perm32(int rho) { const int n = rho >> 4, i = rho & 15; return 8 * (i >> 2) + 4 * n + (i & 3); }

struct Unit { int pm, pn; };
struct Gemm { const bf16_t* A; const bf16_t* Bt; int M, N, K, lda, ldb; };

struct StaticOrder {
    int nM, nN, nwg, G, c;
    __host__ __device__ void init(int M, int N, int G_, int c_) { nM = M / BM; nN = N / BM; nwg = nM * nN; G = G_; c = c_; }
    __host__ __device__ bool next(int i, Unit& u) const {
        const long L = (long)i * G + c; if (L >= nwg) return false;
        int wgid = (int)L; { const int q = nwg / NXCD, r = nwg % NXCD, xcd = wgid % NXCD, off = wgid / NXCD; wgid = (xcd < r ? xcd * (q + 1) : r * (q + 1) + (xcd - r) * q) + off; }
        const int nig = WGM * nN, gid = wgid / nig, fm = gid * WGM, gsz = (nM - fm) < WGM ? (nM - fm) : WGM;
        u.pm = fm + ((wgid % nig) % gsz); u.pn = (wgid % nig) / gsz; return true;
    }
    __device__ __forceinline__ void a_ready(const Unit&) const {}
    __device__ __forceinline__ void done(const Unit&) const {}
};

__device__ __forceinline__ f32x2 gelu_pk(f32x2 v) {
    const f32x2 av = __builtin_elementwise_abs(v), d = av * 0.2316418882f + 1.0f;
    f32x2 t; t.x = __builtin_amdgcn_rcpf(d.x); t.y = __builtin_amdgcn_rcpf(d.y);
    f32x2 q = t * 0.5307027145f + (-0.7265760135f); q = q * t + 0.7107068705f; q = q * t + (-0.142248368f); q = q * t + 0.127414796f; q = q * t;
    const f32x2 s = (v * v) * (-0.72134752044f);
    f32x2 e; e.x = __builtin_amdgcn_exp2f(s.x); e.y = __builtin_amdgcn_exp2f(s.y);
    const f32x2 m = v * (q * e), r = v - m;
    f32x2 o; o.x = v.x < 0.f ? m.x : r.x; o.y = v.y < 0.f ? m.y : r.y; return o;
}

struct EpiAct {
    static constexpr bool PERM = true, AFTER_DRAIN = false;
    bf16_t* O; int ldc; int act; float* ssq; int ssq_pn0;
    int qfrag;
    __device__ __forceinline__ void operator()(const f32x4 (&acc)[2][2][4][2], const Unit& u, int wr, int wc, int fr, int fq) const {
        const int row0 = u.pm * BM + wr * 64 + fr; const int col0 = u.pn * BM + wc * 32 + 8 * fq;
        const bool do_ssq = (ssq != nullptr) && (u.pn >= ssq_pn0);
        const __amdgpu_buffer_rsrc_t rsrc = __builtin_amdgcn_make_buffer_rsrc((void*)O, 0, 0x7fffffff, 0x00020000);
#pragma unroll
        for (int ai = 0; ai < 2; ++ai)
#pragma unroll
            for (int m = 0; m < 4; ++m) { const int row = row0 + ai * HALF + m * 16; bf16_t* rowp = O + (size_t)row * ldc + col0; float ss = 0.f;
#pragma unroll
                for (int bj = 0; bj < 2; ++bj) { f32x4 v0 = acc[ai][bj][m][0], v1 = acc[ai][bj][m][1];
                    if (act == 1) { f32x2 a = gelu_pk((f32x2){v0[0], v0[1]}), b = gelu_pk((f32x2){v0[2], v0[3]}), c = gelu_pk((f32x2){v1[0], v1[1]}), d = gelu_pk((f32x2){v1[2], v1[3]});
                        v0 = (f32x4){a.x, a.y, b.x, b.y}; v1 = (f32x4){c.x, c.y, d.x, d.y}; }
                    else if (act == 2) { v0 = __builtin_elementwise_max(v0, (f32x4){0.f, 0.f, 0.f, 0.f}); v1 = __builtin_elementwise_max(v1, (f32x4){0.f, 0.f, 0.f, 0.f}); v0 = v0 * v0; v1 = v1 * v1; }
                    ss += (v0[0] * v0[0] + v0[1] * v0[1]) + (v0[2] * v0[2] + v0[3] * v0[3]) + (v1[0] * v1[0] + v1[1] * v1[1]) + (v1[2] * v1[2] + v1[3] * v1[3]);
                    u32x4 w; w.x = cvtpk(v0[0], v0[1]); w.y = cvtpk(v0[2], v0[3]); w.z = cvtpk(v1[0], v1[1]); w.w = cvtpk(v1[2], v1[3]);
                    bf16_t* dst = rowp + bj * HALF;
                    if (qfrag == 1) { const int col = col0 + bj * HALF; dst = O + (((((size_t)((row >> 12) * NH + (col >> 6)) * (SEQ / 32) + ((row & (SEQ - 1)) >> 5)) * 4 + ((col & 63) >> 4)) * 64 + ((col >> 3) & 1) * 32 + (row & 31)) * 8); }
                    if (qfrag == 2) {
                        const int col = col0 + bj * HALF, s = col & (SEQ - 1), kk = s & 31;
                        const size_t it = ((((size_t)((col >> 12) * NH + (row >> 6)) * (SEQ / 32) + (s >> 5)) * 2 + ((row >> 5) & 1)) * 2 + (kk >> 4));
                        const size_t e0 = (it * 64 + (row & 31)) * 8 + 4 * ((kk >> 3) & 1);
                        u32x2 lo2; lo2.x = w.x; lo2.y = w.y; u32x2 hi2; hi2.x = w.z; hi2.y = w.w;
                        __builtin_amdgcn_raw_buffer_store_b64(lo2, rsrc, (unsigned)(e0 * 2), 0, WT_AUX);
                        __builtin_amdgcn_raw_buffer_store_b64(hi2, rsrc, (unsigned)((e0 + 32 * 8) * 2), 0, WT_AUX);
                    } else
                    __builtin_amdgcn_raw_buffer_store_b128(w, rsrc, (unsigned)((size_t)(dst - O) * 2), 0, WT_AUX); }
                if (do_ssq) { ss += __shfl_xor(ss, 16); ss += __shfl_xor(ss, 32); if (fq == 0) ((GAS float*)ssq)[(size_t)((u.pn - ssq_pn0) * 4 + wc) * MTOK + row] = ss; }
            }
    }
};
struct EpiRes {
    static constexpr bool PERM = false, AFTER_DRAIN = false;
    const float* base; float* out; const float* gate; int rowoff;
    __device__ __forceinline__ void operator()(const f32x4 (&acc)[2][2][4][2], const Unit& u, int wr, int wc, int fr, int fq) const {
        const int row0 = rowoff + u.pm * BM + wr * 64 + fr; const int col0 = u.pn * BM + wc * 32 + 4 * fq;
        const GAS float* gp = (const GAS float*)gate + (size_t)((rowoff + u.pm * BM) >> 12) * MODS + col0; const GAS float* gbase = (const GAS float*)base;
        const __amdgpu_buffer_rsrc_t rsrc = __builtin_amdgcn_make_buffer_rsrc((void*)out, 0, 0x7fffffff, 0x00020000);
        f32x4 gv[2][2];
#pragma unroll
        for (int bj = 0; bj < 2; ++bj)
#pragma unroll
            for (int n = 0; n < 2; ++n) gv[bj][n] = *(const GAS f32x4*)(gp + bj * HALF + n * 16);
#pragma unroll
        for (int ai = 0; ai < 2; ++ai) {
            f32x4 bs[4][2][2];
#pragma unroll
            for (int m = 0; m < 4; ++m) { const size_t off = (size_t)(row0 + ai * HALF + m * 16) * DM + col0;
#pragma unroll
                for (int bj = 0; bj < 2; ++bj)
#pragma unroll
                    for (int n = 0; n < 2; ++n) bs[m][bj][n] = *(const GAS f32x4*)(gbase + off + bj * HALF + n * 16); }
#pragma unroll
            for (int m = 0; m < 4; ++m) { const size_t off = (size_t)(row0 + ai * HALF + m * 16) * DM + col0;
#pragma unroll
                for (int bj = 0; bj < 2; ++bj)
#pragma unroll
                    for (int n = 0; n < 2; ++n) { const f32x4 o = bs[m][bj][n] + gv[bj][n] * acc[ai][bj][m][n]; __builtin_amdgcn_raw_buffer_store_b128(__builtin_bit_cast(u32x4, o), rsrc, (unsigned)((off + bj * HALF + n * 16) * 4), 0, WT_AUX); } }
        }
    }
};

template <class Epi, class Sched, bool ALIGN_EPI = false, bool SP2 = false>
__device__ __forceinline__ void gemm_phase(LAS unsigned char* lds, const Gemm g, const Sched& S, const Epi& E, const int tid) {
    const int wid = __builtin_amdgcn_readfirstlane(tid >> 6), lane = tid & 63, wr = wid >> 2, wc = wid & 3, fr = lane & 15, fq = lane >> 4;
    const int K = g.K, nt = K / BK;
    unsigned voffA[2], voffB[2];
#pragma unroll
    for (int i = 0; i < 2; ++i) { int R, C; stage_rc(tid * 16 + i * 8192, R, C); const int Rb = Epi::PERM ? ((R & ~31) + perm32(R & 31)) : R;
        voffA[i] = (unsigned)(R * g.lda + C) * 2u; voffB[i] = (unsigned)(Rb * g.ldb + C) * 2u; }
    const size_t kstep = (size_t)(BK * 2);
    const size_t hstepA = (size_t)HALF * g.lda * 2, hstepB = (size_t)HALF * g.ldb * 2;
    const size_t tstepA = 2 * hstepA, tstepB = 2 * hstepB;
    const unsigned ldsw = (unsigned)wid * 1024u;
    const int aoff = lds_byte(wr * 64 + fr, fq * 8), boff = lds_byte(wc * 32 + fr, fq * 8);
#define PG8_SA(b, h) (((b) * 2 + (h)) * HTB)
#define PG8_SB(b, h) ((4 + (b) * 2 + (h)) * HTB)
#define PG8_STAGE(bufoff, gbase, voff) do { _Pragma("unroll") for (int _i = 0; _i < 2; ++_i) \
        __builtin_amdgcn_global_load_lds((const unsigned*)((const char*)(gbase) + (voff)[_i]), (LAS unsigned*)(lds + (bufoff) + ldsw + _i * 8192), 16, 0, 0); } while (0)
#define PG8_LDA(dst, b, h) do { _Pragma("unroll") for (int m = 0; m < 4; ++m) _Pragma("unroll") for (int k = 0; k < 2; ++k) dst[m][k] = *(const LAS bf16x8*)(lds + PG8_SA(b, h) + aoff + m * 2048 + k * 1024); } while (0)
#define PG8_LDB(dst, b, h) do { _Pragma("unroll") for (int n = 0; n < 2; ++n) _Pragma("unroll") for (int k = 0; k < 2; ++k) dst[n][k] = *(const LAS bf16x8*)(lds + PG8_SB(b, h) + boff + n * 2048 + k * 1024); } while (0)
#define PG8_MMA(ai, bj, At, Bt) do { __builtin_amdgcn_s_setprio(1); _Pragma("unroll") for (int m = 0; m < 4; ++m) _Pragma("unroll") for (int n = 0; n < 2; ++n) _Pragma("unroll") for (int k = 0; k < 2; ++k) \
        acc[ai][bj][m][n] = __builtin_amdgcn_mfma_f32_16x16x32_bf16(Bt[n][k], At[m][k], acc[ai][bj][m][n], 0, 0, 0); __builtin_amdgcn_s_setprio(0); } while (0)
#define PG8_WAIT_V(n) asm volatile("s_waitcnt vmcnt(" #n ")" ::: "memory")
#define PG8_WAIT_L(n) asm volatile("s_waitcnt lgkmcnt(" #n ")" ::: "memory")
#define PG8_BAR __builtin_amdgcn_s_barrier()
#define PG8_SCHED __builtin_amdgcn_sched_barrier(0)
    Unit cur, nxt; int ui = 0;
    if (!S.next(0, cur)) return;
    f32x4 acc[2][2][4][2];
#pragma unroll
    for (int a = 0; a < 2; ++a)
#pragma unroll
        for (int b = 0; b < 2; ++b)
#pragma unroll
            for (int m = 0; m < 4; ++m)
#pragma unroll
                for (int n = 0; n < 2; ++n) acc[a][b][m][n] = (f32x4){0.f, 0.f, 0.f, 0.f};
    bf16x8 At[4][2], B0[2][2], B1[2][2];
    const char* cA = (const char*)g.A + (size_t)cur.pm * tstepA; const char* cB = (const char*)g.Bt + (size_t)cur.pn * tstepB;
    S.a_ready(cur);
    if constexpr (SP2) {
        PG8_STAGE(PG8_SB(0, 0), cB, voffB); PG8_STAGE(PG8_SB(0, 1), cB + hstepB, voffB); PG8_STAGE(PG8_SA(0, 0), cA, voffA); PG8_STAGE(PG8_SA(0, 1), cA + hstepA, voffA);
        if (wr == 1) PG8_BAR;
        PG8_WAIT_V(2); PG8_BAR;
        PG8_STAGE(PG8_SB(1, 0), cB + kstep, voffB); PG8_STAGE(PG8_SA(1, 0), cA + kstep, voffA); PG8_STAGE(PG8_SB(1, 1), cB + hstepB + kstep, voffB);
        PG8_WAIT_V(6); PG8_BAR;
    } else {
        PG8_STAGE(PG8_SB(0, 0), cB, voffB); PG8_STAGE(PG8_SA(0, 0), cA, voffA); PG8_STAGE(PG8_SB(0, 1), cB + hstepB, voffB); PG8_STAGE(PG8_SA(0, 1), cA + hstepA, voffA);
        if (wr == 1) PG8_BAR;
        PG8_WAIT_V(4); PG8_BAR;
        PG8_STAGE(PG8_SB(1, 0), cB + kstep, voffB); PG8_STAGE(PG8_SA(1, 0), cA + kstep, voffA); PG8_STAGE(PG8_SB(1, 1), cB + hstepB + kstep, voffB);
        PG8_WAIT_V(6); PG8_BAR;
    }
    for (;;) {
        const bool has_next = S.next(ui + 1, nxt);
        const char* nA = has_next ? (const char*)g.A + (size_t)nxt.pm * tstepA : cA; const char* nB = has_next ? (const char*)g.Bt + (size_t)nxt.pn * tstepB : cB;
        for (int t = 0; t < nt; t += 2) {
            const bool last = (t == nt - 2);
            const char* a1 = cA + (size_t)(t + 1) * kstep;
            const char* a2 = last ? nA : cA + (size_t)(t + 2) * kstep; const char* b2 = last ? nB : cB + (size_t)(t + 2) * kstep;
            const char* a3 = a2 + kstep; const char* b3 = b2 + kstep;
            if (last && has_next) S.a_ready(nxt);
            if constexpr (SP2) {
            PG8_LDB(B0, 0, 0); PG8_LDB(B1, 0, 1); PG8_SCHED; PG8_LDA(At, 0, 0); PG8_STAGE(PG8_SA(1, 1), a1 + hstepA, voffA);
            PG8_WAIT_V(8); PG8_WAIT_L(0); PG8_BAR; PG8_MMA(0, 0, At, B0); PG8_MMA(0, 1, At, B1); PG8_BAR; PG8_SCHED;
            PG8_LDA(At, 0, 1); PG8_STAGE(PG8_SB(0, 0), b2, voffB); PG8_STAGE(PG8_SB(0, 1), b2 + hstepB, voffB); PG8_STAGE(PG8_SA(0, 0), a2, voffA);
            PG8_WAIT_V(8); PG8_WAIT_L(0); PG8_BAR; PG8_MMA(1, 0, At, B0); PG8_MMA(1, 1, At, B1); PG8_BAR; PG8_SCHED;
            PG8_LDB(B0, 1, 0); PG8_LDB(B1, 1, 1); PG8_SCHED; PG8_LDA(At, 1, 0); PG8_STAGE(PG8_SA(0, 1), a2 + hstepA, voffA);
            PG8_WAIT_V(8); PG8_WAIT_L(0); PG8_BAR; PG8_MMA(0, 0, At, B0); PG8_MMA(0, 1, At, B1); PG8_BAR; PG8_SCHED;
            PG8_LDA(At, 1, 1); PG8_STAGE(PG8_SB(1, 0), b3, voffB); PG8_STAGE(PG8_SB(1, 1), b3 + hstepB, voffB); PG8_STAGE(PG8_SA(1, 0), a3, voffA);
            PG8_WAIT_V(8); PG8_WAIT_L(0); PG8_BAR; PG8_MMA(1, 0, At, B0); PG8_MMA(1, 1, At, B1); PG8_BAR; PG8_SCHED;
            } else {
            PG8_LDB(B0, 0, 0); PG8_SCHED; PG8_LDA(At, 0, 0); PG8_STAGE(PG8_SA(1, 1), a1 + hstepA, voffA);
            PG8_WAIT_L(8); PG8_BAR; PG8_WAIT_L(0); PG8_MMA(0, 0, At, B0); PG8_BAR; PG8_SCHED;
            PG8_LDB(B1, 0, 1); PG8_STAGE(PG8_SB(0, 0), b2, voffB);
            PG8_BAR; PG8_WAIT_L(0); PG8_MMA(0, 1, At, B1); PG8_BAR;
            PG8_LDA(At, 0, 1); PG8_STAGE(PG8_SA(0, 0), a2, voffA);
            PG8_BAR; PG8_WAIT_L(0); PG8_MMA(1, 0, At, B0); PG8_BAR; PG8_SCHED;
            PG8_STAGE(PG8_SB(0, 1), b2 + hstepB, voffB);
            PG8_WAIT_V(6); PG8_BAR; PG8_MMA(1, 1, At, B1); PG8_BAR;
            PG8_LDB(B0, 1, 0); PG8_SCHED; PG8_LDA(At, 1, 0); PG8_STAGE(PG8_SA(0, 1), a2 + hstepA, voffA);
            PG8_WAIT_L(8); PG8_BAR; PG8_WAIT_L(0); PG8_MMA(0, 0, At, B0); PG8_BAR; PG8_SCHED;
            PG8_LDB(B1, 1, 1); PG8_STAGE(PG8_SB(1, 0), b3, voffB);
            PG8_BAR; PG8_WAIT_L(0); PG8_MMA(0, 1, At, B1); PG8_BAR;
            PG8_LDA(At, 1, 1); PG8_STAGE(PG8_SA(1, 0), a3, voffA);
            PG8_BAR; PG8_WAIT_L(0); PG8_MMA(1, 0, At, B0); PG8_BAR; PG8_SCHED;
            PG8_STAGE(PG8_SB(1, 1), b3 + hstepB, voffB);
            PG8_WAIT_V(6); PG8_BAR; PG8_MMA(1, 1, At, B1); PG8_BAR;
            }
        }
        if constexpr (ALIGN_EPI) { if (wr == 0) PG8_BAR; }
        if constexpr (!Epi::AFTER_DRAIN) { E(acc, cur, wr, wc, fr, fq); S.done(cur); }
        if (!has_next) break;
#pragma unroll
        for (int a = 0; a < 2; ++a)
#pragma unroll
            for (int b = 0; b < 2; ++b)
#pragma unroll
                for (int m = 0; m < 4; ++m)
#pragma unroll
                    for (int n = 0; n < 2; ++n) acc[a][b][m][n] = (f32x4){0.f, 0.f, 0.f, 0.f};
        cur = nxt; cA = nA; cB = nB; ++ui;
        if constexpr (ALIGN_EPI) { if (wr == 1) PG8_BAR; }
    }
    PG8_WAIT_V(0);
    if constexpr (!ALIGN_EPI) { if (wr == 0) PG8_BAR; }
    PG8_BAR;
#undef PG8_SA
#undef PG8_SB
#undef PG8_STAGE
#undef PG8_LDA
#undef PG8_LDB
#undef PG8_MMA
#undef PG8_WAIT_V
#undef PG8_WAIT_L
#undef PG8_BAR
#undef PG8_SCHED
}
}

struct Params {
    const float *x, *c, *mod_w, *mod_b, *norm_g, *w_up, *w_down, *a_w_in, *a_vg, *a_ws, *a_bs, *a_w_out, *kv_mod_w, *kv_mod_b, *kv_norm_g, *kv_w, *k_norm_g, *b_w_q, *q_norm_g, *b_w_out;
    float* out; unsigned char* ws;
};

struct TrItem { const GAS float* W; GAS bf16_t* WT; int K, N, item; };
DI void tr_load(const TrItem& t, f32x4 (&v)[16], int lane) {
    const int nblk = t.N / 64, kb = t.item / nblk, nb = t.item % nblk, k0 = 64 * kb, n0 = 64 * nb;
    const GAS float* wp = t.W + (size_t)(k0 + (lane >> 4)) * t.N + n0 + (lane & 15) * 4;
#pragma unroll
    for (int i = 0; i < 16; ++i) v[i] = *(const GAS f32x4*)(wp + (size_t)(4 * i) * t.N);
}
DI void tr_finish(const TrItem& t, const f32x4 (&v)[16], LAS float* scr, int lane) {
    const int nblk = t.N / 64, kb = t.item / nblk, nb = t.item % nblk, k0 = 64 * kb, n0 = 64 * nb;
    LAS float* sp = scr + (lane >> 4) * 65 + (lane & 15) * 4;
#pragma unroll
    for (int i = 0; i < 16; ++i) { LAS float* d = sp + (4 * i) * 65; d[0] = v[i].x; d[1] = v[i].y; d[2] = v[i].z; d[3] = v[i].w; }
    asm volatile("s_waitcnt lgkmcnt(0)" ::: "memory");
    const int c = lane & 7;
#pragma unroll
    for (int j = 0; j < 8; ++j) { const int n = (lane >> 3) + 8 * j; const LAS float* s = scr + (8 * c) * 65 + n;
        u32x4 o; o.x = cvtpk(s[0 * 65], s[1 * 65]); o.y = cvtpk(s[2 * 65], s[3 * 65]); o.z = cvtpk(s[4 * 65], s[5 * 65]); o.w = cvtpk(s[6 * 65], s[7 * 65]);
        *(GAS u32x4*)(t.WT + (size_t)(n0 + n) * t.K + k0 + 8 * c) = o; }
    asm volatile("s_waitcnt lgkmcnt(0)" ::: "memory");
}
DI TrItem tr_decode(const Params& p, int r) {
    GAS unsigned char* wsw = (GAS unsigned char*)p.ws;
    if (r < 4096) { const int l = r >> 10; return TrItem{(const GAS float*)p.w_up + (size_t)l * DM * DFF, (GAS bf16_t*)(wsw + ws_up(l)), DM, DFF, r & 1023}; } r -= 4096;
    if (r < 4096) { const int l = r >> 10; return TrItem{(const GAS float*)p.w_down + (size_t)l * DM * DFF, (GAS bf16_t*)(wsw + ws_dn(l)), DFF, DM, r & 1023}; } r -= 4096;
    if (r < 2048) { const int l = r >> 10; return TrItem{(const GAS float*)p.a_w_in + (size_t)l * DM * 2 * GW, (GAS bf16_t*)(wsw + WS_WIN) + (size_t)l * DM * 2 * GW, DM, 2 * GW, r & 1023}; } r -= 2048;
    if (r < 1024) { const int l = r >> 9; return TrItem{(const GAS float*)p.a_w_out + (size_t)l * GW * DM, (GAS bf16_t*)(wsw + WS_WAO) + (size_t)l * GW * DM, GW, DM, r & 511}; } r -= 1024;
    if (r < 512) { return TrItem{(const GAS float*)p.kv_w, (GAS bf16_t*)(wsw + WS_WKV), DM, 2 * DM, r}; } r -= 512;
    if (r < 512) { const int l = r >> 8; return TrItem{(const GAS float*)p.b_w_q + (size_t)l * DM * DM, (GAS bf16_t*)(wsw + WS_WQ) + (size_t)l * DM * DM, DM, DM, r & 255}; } r -= 512;
    { const int l = r >> 8; return TrItem{(const GAS float*)p.b_w_out + (size_t)l * DM * DM, (GAS bf16_t*)(wsw + WS_WBO) + (size_t)l * DM * DM, DM, DM, r & 255}; }
}

DI void p0_phase(const Params& p, LAS unsigned char* lds, int tid, int wave, int lane, int G, int bid) {
    GAS float* MOD = (GAS float*)(p.ws + WS_MOD);
    LAS float* cs = (LAS float*)lds;
    LAS float* red = (LAS float*)(lds + 32768);
    for (int i = tid; i < 8 * DM; i += NTHREADS) { const int b = i >> 10, k = i & 1023; cs[k * 8 + b] = ((const GAS float*)p.c)[i]; }
    __syncthreads();
    for (int it = bid; it < 416; it += G) {
        const GAS float* W; const GAS float* bias; GAS float* outp; int ldw, n0;
        if (it < 384) { const int l = it / 96; n0 = (it % 96) * 64; W = (const GAS float*)p.mod_w + (size_t)l * DM * MODS; ldw = MODS; bias = (const GAS float*)p.mod_b + l * MODS; outp = MOD + (size_t)l * 8 * MODS; }
        else { n0 = (it - 384) * 64; W = (const GAS float*)p.kv_mod_w; ldw = 2 * DM; bias = (const GAS float*)p.kv_mod_b; outp = MOD + (size_t)4 * 8 * MODS; }
        const GAS float* wp = W + (size_t)(wave * 128) * ldw + n0 + lane;
        float a0 = 0.f, a1 = 0.f, a2 = 0.f, a3 = 0.f, a4 = 0.f, a5 = 0.f, a6 = 0.f, a7 = 0.f;
#pragma unroll 32
        for (int kk = 0; kk < 128; ++kk) { const float w = wp[(size_t)kk * ldw]; const LAS f32x4* cp = (const LAS f32x4*)(cs + (wave * 128 + kk) * 8); const f32x4 c0 = cp[0], c1 = cp[1];
            a0 += w * c0.x; a1 += w * c0.y; a2 += w * c0.z; a3 += w * c0.w; a4 += w * c1.x; a5 += w * c1.y; a6 += w * c1.z; a7 += w * c1.w; }
        LAS float* rp = red + wave * 512 + lane;
        rp[0] = a0; rp[64] = a1; rp[128] = a2; rp[192] = a3; rp[256] = a4; rp[320] = a5; rp[384] = a6; rp[448] = a7;
        __syncthreads();
        { const int b = tid >> 6; float s = bias[n0 + lane];
#pragma unroll
          for (int w = 0; w < 8; ++w) s += red[w * 512 + b * 64 + lane];
          outp[(size_t)b * MODS + n0 + lane] = s; }
        __syncthreads();
    }
    __syncthreads();
    LAS float* scr = (LAS float*)(lds + wave * 16640);
    const int gw = bid * 8 + wave, NGW = G * 8;
    if (gw < 12800) {
        TrItem cur = tr_decode(p, gw); f32x4 v[16]; tr_load(cur, v, lane);
        for (int it = gw; it < 12800; it += NGW) {
            const int itn = it + NGW < 12800 ? it + NGW : it;
            const TrItem nxt = tr_decode(p, itn); f32x4 vn[16]; tr_load(nxt, vn, lane);
            __builtin_amdgcn_sched_barrier(0);
            tr_finish(cur, v, scr, lane);
            cur = nxt;
#pragma unroll
            for (int i = 0; i < 16; ++i) v[i] = vn[i];
        }
    }
}

template <bool KNORM>
DI void norm_phase(const float* x_, const float* g_, const float* sh_, const float* sc_, bf16_t* XN_, const float* g2_, const float* sh2_, const float* sc2_, bf16_t* XN2_, bool skipx, const bf16_t* Kb_, const float* kg_, bf16_t* Kf_, const bf16_t* Vt_, bf16_t* Vf_, int wave, int lane, int G, int bid) {
    const GAS float* x = (const GAS float*)x_; const GAS float* g = (const GAS float*)g_; const GAS float* sh = (const GAS float*)sh_; const GAS float* sc = (const GAS float*)sc_; GAS bf16_t* XN = (GAS bf16_t*)XN_;
    const GAS bf16_t* Kb = (const GAS bf16_t*)Kb_; const GAS float* kg = (const GAS float*)kg_; GAS bf16_t* Kf = (GAS bf16_t*)Kf_; const GAS bf16_t* Vt = (const GAS bf16_t*)Vt_; GAS bf16_t* Vf = (GAS bf16_t*)Vf_;
    const GAS float* g2 = (const GAS float*)g2_; const GAS float* sh2 = (const GAS float*)sh2_; const GAS float* sc2 = (const GAS float*)sc2_; GAS bf16_t* XN2 = (GAS bf16_t*)XN2_;
    const bool dual = XN2_ != nullptr;
    const int gw = bid * 8 + wave, NGW = G * 8;
    for (int chunk = gw; chunk < MTOK / 16; chunk += NGW) {
      const int b = (chunk * 16) >> 12;
      f32x4 wm[4], hh[4], wm2[4], hh2[4];
#pragma unroll
      for (int j = 0; j < 4; ++j) { const int idx = 4 * lane + 256 * j;
          if (!skipx) { wm[j] = *(const GAS f32x4*)(g + idx) * (*(const GAS f32x4*)(sc + (size_t)b * MODS + idx) + 1.0f); hh[j] = *(const GAS f32x4*)(sh + (size_t)b * MODS + idx); }
          else { wm[j] = (f32x4){0.f, 0.f, 0.f, 0.f}; hh[j] = wm[j]; }
          if (dual) { wm2[j] = *(const GAS f32x4*)(g2 + idx) * (*(const GAS f32x4*)(sc2 + (size_t)b * MODS + idx) + 1.0f); hh2[j] = *(const GAS f32x4*)(sh2 + (size_t)b * MODS + idx); }
          else { wm2[j] = (f32x4){0.f, 0.f, 0.f, 0.f}; hh2[j] = wm2[j]; } }
#pragma unroll 1
      for (int half = skipx ? 4 : 0; half < 4; ++half) {
          f32x4 v[4][4];
#pragma unroll
          for (int r = 0; r < 4; ++r) { const GAS f32x4* xr = (const GAS f32x4*)(x + (size_t)(chunk * 16 + half * 4 + r) * DM) + lane;
#pragma unroll
              for (int j = 0; j < 4; ++j) v[r][j] = xr[64 * j]; }
          float rstd[4];
#pragma unroll
          for (int r = 0; r < 4; ++r) { float s = 0.f;
#pragma unroll
              for (int j = 0; j < 4; ++j) s += (v[r][j].x * v[r][j].x + v[r][j].y * v[r][j].y) + (v[r][j].z * v[r][j].z + v[r][j].w * v[r][j].w);
              rstd[r] = rsqrtf(wave_sum(s) * (1.f / DM) + EPS); }
#pragma unroll
          for (int r = 0; r < 4; ++r) { GAS u32x2* o8 = (GAS u32x2*)(XN + (size_t)(chunk * 16 + half * 4 + r) * DM) + lane;
#pragma unroll
              for (int j = 0; j < 4; ++j) { const f32x4 y = (v[r][j] * rstd[r]) * wm[j] + hh[j];
                  u32x2 w; w.x = cvtpk(y.x, y.y); w.y = cvtpk(y.z, y.w); o8[64 * j] = w; }
              if (dual) { GAS u32x2* p8 = (GAS u32x2*)(XN2 + (size_t)(chunk * 16 + half * 4 + r) * DM) + lane;
#pragma unroll
                  for (int j = 0; j < 4; ++j) { const f32x4 y = (v[r][j] * rstd[r]) * wm2[j] + hh2[j];
                      u32x2 w; w.x = cvtpk(y.x, y.y); w.y = cvtpk(y.z, y.w); p8[64 * j] = w; } } }
      }
      u32x4 kc0, kc1;
      if (KNORM) { const GAS u32x4* kp = (const GAS u32x4*)(Kb + (size_t)(chunk * 16) * DM + 16 * lane); kc0 = kp[0]; kc1 = kp[1]; }
      if (KNORM) for (int i = 0; i < 16; ++i) {
        const int row = chunk * 16 + i;
        u32x4 kn0, kn1;
        { const int rn = chunk * 16 + (i < 15 ? i + 1 : 15);
          const GAS u32x4* kp = (const GAS u32x4*)(Kb + (size_t)rn * DM + 16 * lane); kn0 = kp[0]; kn1 = kp[1]; }
        __builtin_amdgcn_sched_barrier(0);
        if (KNORM) {
            const u32x4 k0 = kc0, k1 = kc1;
            float f[16];
            f[0] = bflo(k0.x); f[1] = bfhi(k0.x); f[2] = bflo(k0.y); f[3] = bfhi(k0.y); f[4] = bflo(k0.z); f[5] = bfhi(k0.z); f[6] = bflo(k0.w); f[7] = bfhi(k0.w);
            f[8] = bflo(k1.x); f[9] = bfhi(k1.x); f[10] = bflo(k1.y); f[11] = bfhi(k1.y); f[12] = bflo(k1.z); f[13] = bfhi(k1.z); f[14] = bflo(k1.w); f[15] = bfhi(k1.w);
            float ss = 0.f;
#pragma unroll
            for (int e = 0; e < 16; ++e) ss += f[e] * f[e];
            ss += __shfl_xor(ss, 1); ss += __shfl_xor(ss, 2);
            const float kr = rsqrtf(ss * (1.f / HD) + EPS);
            const GAS float* kgp = kg + ((16 * lane) & 63);
#pragma unroll
            for (int e = 0; e < 16; ++e) f[e] = f[e] * kr * kgp[e];
            u32x4 o0, o1;
            o0.x = cvtpk(f[0], f[1]); o0.y = cvtpk(f[2], f[3]); o0.z = cvtpk(f[4], f[5]); o0.w = cvtpk(f[6], f[7]);
            o1.x = cvtpk(f[8], f[9]); o1.y = cvtpk(f[10], f[11]); o1.z = cvtpk(f[12], f[13]); o1.w = cvtpk(f[14], f[15]);
            const int s = row & (SEQ - 1), hh = lane >> 2, d0 = lane & 3;
            GAS bf16_t* dst = Kf + ((((size_t)(b * NH + hh) * (SEQ / 32) + (s >> 5)) * 4 + d0) * 64 + (s & 31)) * 8;
            *(GAS u32x4*)dst = o0; *(GAS u32x4*)(dst + 32 * 8) = o1;
            kc0 = kn0; kc1 = kn1;
        }
      }
    }
}

DI void knorm_own_units(bf16_t* Kf_, const float* kg_, const pg8::StaticOrder& S, int wave, int lane) {
    GAS bf16_t* Kf = (GAS bf16_t*)Kf_; const GAS float* kg = (const GAS float*)kg_;
    const int hi = lane >> 5;
    f32x4 gq[4][2];
#pragma unroll
    for (int d0 = 0; d0 < 4; ++d0) { gq[d0][0] = *(const GAS f32x4*)(kg + d0 * 16 + hi * 8); gq[d0][1] = *(const GAS f32x4*)(kg + d0 * 16 + hi * 8 + 4); }
    pg8::Unit un;
    for (int ui = 0; S.next(ui, un); ++ui) {
        const int b = un.pm >> 4, tile0 = (un.pm & 15) * 8, h0 = un.pn * 4;
#pragma unroll 1
        for (int pr = 0; pr < 2; ++pr) {
            u32x4 kq[2][4]; int its[2];
#pragma unroll
            for (int k = 0; k < 2; ++k) { const int idx = wave * 4 + pr * 2 + k; its[k] = ((b * NH + h0 + (idx >> 3)) * (SEQ / 32)) + tile0 + (idx & 7);
#pragma unroll
                for (int d0 = 0; d0 < 4; ++d0) kq[k][d0] = *(const GAS u32x4*)(Kf + ((size_t)its[k] * 4 + d0) * 512 + lane * 8); }
#pragma unroll
            for (int k = 0; k < 2; ++k) {
                float ss = 0.f;
#pragma unroll
                for (int d0 = 0; d0 < 4; ++d0) { const u32x4 q = kq[k][d0];
                    const float f0 = bflo(q.x), f1 = bfhi(q.x), f2 = bflo(q.y), f3 = bfhi(q.y), f4 = bflo(q.z), f5 = bfhi(q.z), f6 = bflo(q.w), f7 = bfhi(q.w);
                    ss += (f0 * f0 + f1 * f1) + (f2 * f2 + f3 * f3) + (f4 * f4 + f5 * f5) + (f6 * f6 + f7 * f7); }
                ss += __shfl_xor(ss, 32);
                const float kr = rsqrtf(ss * (1.f / HD) + EPS);
#pragma unroll
                for (int d0 = 0; d0 < 4; ++d0) { const u32x4 q = kq[k][d0]; const f32x4 g0 = gq[d0][0], g1 = gq[d0][1];
                    u32x4 w; w.x = cvtpk(bflo(q.x) * kr * g0.x, bfhi(q.x) * kr * g0.y); w.y = cvtpk(bflo(q.y) * kr * g0.z, bfhi(q.y) * kr * g0.w);
                    w.z = cvtpk(bflo(q.z) * kr * g1.x, bfhi(q.z) * kr * g1.y); w.w = cvtpk(bflo(q.w) * kr * g1.z, bfhi(q.w) * kr * g1.w);
                    *(GAS u32x4*)(Kf + ((size_t)its[k] * 4 + d0) * 512 + lane * 8) = w; } }
        }
    }
}

DI void spatial_phase(LAS unsigned char* lds, bf16_t* UV_, const float* ssq_, const float* Wsp_, const float* bsp_, const float* gvn_, int tid, int wave, int lane, int G, int bid, bool dummy) {
    GAS bf16_t* UV = (GAS bf16_t*)UV_; const GAS float* ssq = (const GAS float*)ssq_; const GAS float* Wsp = (const GAS float*)Wsp_; const GAS float* bsp = (const GAS float*)bsp_; const GAS float* gvn = (const GAS float*)gvn_;
    constexpr int PITCH = 136;
    LAS float* rs = (LAS float*)lds;
    LAS bf16_t* Wl = (LAS bf16_t*)(lds + 1024);
    LAS bf16_t* vT = (LAS bf16_t*)(lds + 1024 + 128 * PITCH * 2);
    const int ql = lane & 31, hi = lane >> 5;
    for (int it = bid; it < 2048; it += G) {
        const int g = it & 7, n = it >> 3;
        const size_t tok0 = (size_t)n * 128;
        if (tid < 128) { const GAS float* pp = ssq + tok0 + tid; float sq[32];
#pragma unroll
            for (int i = 0; i < 32; ++i) sq[i] = pp[(size_t)i * MTOK];
            float s = 0.f;
#pragma unroll
            for (int i = 0; i < 32; i += 4) s += (sq[i] + sq[i + 1]) + (sq[i + 2] + sq[i + 3]);
            rs[tid] = rsqrtf(s * (1.f / GW) + EPS); }
        __syncthreads();
#pragma unroll
        for (int i = 0; i < 4; ++i) { const int idx = i * NTHREADS + tid, t = idx >> 4, s8 = (idx & 15) * 8;
            const GAS float* wp = Wsp + ((size_t)g * 128 + t) * 128 + s8; const f32x4 a = *(const GAS f32x4*)wp, b = *(const GAS f32x4*)(wp + 4);
            const LAS f32x4* rp = (const LAS f32x4*)(rs + s8); const f32x4 r0 = rp[0], r1 = rp[1];
            float w[8] = {a.x * r0.x, a.y * r0.y, a.z * r0.z, a.w * r0.w, b.x * r1.x, b.y * r1.y, b.z * r1.z, b.w * r1.w};
#pragma unroll
            for (int e = 0; e < 8; ++e) w[e] = (s8 + e <= t) ? w[e] : 0.f;
            u32x4 o; o.x = cvtpk(w[0], w[1]); o.y = cvtpk(w[2], w[3]); o.z = cvtpk(w[4], w[5]); o.w = cvtpk(w[6], w[7]);
            *(LAS u32x4*)(Wl + t * PITCH + s8) = o; }
        u32x4 vq[8];
#pragma unroll
        for (int i = 0; i < 8; ++i) { const int idx = i * NTHREADS + tid, s = idx & 127, c8 = (idx >> 7) * 8; vq[i] = *(const GAS u32x4*)(UV + (tok0 + s) * UVP + GW + g * 256 + c8); }
#pragma unroll
        for (int i = 0; i < 8; ++i) { const int idx = i * NTHREADS + tid, s = idx & 127, c8 = (idx >> 7) * 8;
            const u32x4 v = vq[i];
            LAS bf16_t* d = vT + c8 * PITCH + s;
            d[0 * PITCH] = (bf16_t)(v.x & 0xffffu); d[1 * PITCH] = (bf16_t)(v.x >> 16); d[2 * PITCH] = (bf16_t)(v.y & 0xffffu); d[3 * PITCH] = (bf16_t)(v.y >> 16);
            d[4 * PITCH] = (bf16_t)(v.z & 0xffffu); d[5 * PITCH] = (bf16_t)(v.z >> 16); d[6 * PITCH] = (bf16_t)(v.w & 0xffffu); d[7 * PITCH] = (bf16_t)(v.w >> 16); }
        __syncthreads();
        f32x16 acc[4];
#pragma unroll
        for (int tb = 0; tb < 4; ++tb)
#pragma unroll
            for (int r = 0; r < 16; ++r) acc[tb][r] = 0.f;
#pragma unroll
        for (int ks = 0; ks < 8; ++ks) {
            const bf16x8 a = *(const LAS bf16x8*)(vT + (wave * 32 + ql) * PITCH + ks * 16 + hi * 8);
#pragma unroll
            for (int tb = 0; tb < 4; ++tb) if (2 * (tb + 1) > ks) {
                const bf16x8 bb = *(const LAS bf16x8*)(Wl + (tb * 32 + ql) * PITCH + ks * 16 + hi * 8);
                acc[tb] = __builtin_amdgcn_mfma_f32_32x32x16_bf16(a, bb, acc[tb], 0, 0, 0); }
        }
        __syncthreads();
        LAS float* Zs = (LAS float*)lds;
#pragma unroll
        for (int h = 0; h < 2; ++h) {
#pragma unroll
            for (int q = 0; q < 2; ++q) { const int tb = 2 * h + q, tl = q * 32 + ql;
                const float bbias = bsp[g * 128 + tb * 32 + ql];
                const GAS float* gp = gvn + g * 256 + wave * 32 + 4 * hi;
                f32x4 ggv[4];
#pragma unroll
                for (int rg = 0; rg < 4; ++rg) ggv[rg] = *(const GAS f32x4*)(gp + 8 * rg);
#pragma unroll
                for (int rg = 0; rg < 4; ++rg) { const f32x4 gg = ggv[rg];
                    f32x4 z; z.x = acc[tb][4 * rg + 0] * gg.x + bbias; z.y = acc[tb][4 * rg + 1] * gg.y + bbias; z.z = acc[tb][4 * rg + 2] * gg.z + bbias; z.w = acc[tb][4 * rg + 3] * gg.w + bbias;
                    *(LAS f32x4*)(Zs + tl * 260 + wave * 32 + 8 * rg + 4 * hi) = z; } }
            __syncthreads();
            u32x4 uq[4];
#pragma unroll
            for (int i = 0; i < 4; ++i) { const int p = i * NTHREADS + tid, t = p >> 5, c8 = (p & 31) * 8; uq[i] = *(const GAS u32x4*)(UV + (tok0 + 64 * h + t) * UVP + g * 256 + c8); }
#pragma unroll
            for (int i = 0; i < 4; ++i) { const int p = i * NTHREADS + tid, t = p >> 5, c8 = (p & 31) * 8;
                GAS bf16_t* up = UV + (tok0 + 64 * h + t) * UVP + g * 256 + c8;
                const u32x4 uu = uq[i];
                const LAS f32x4* zp = (const LAS f32x4*)(Zs + t * 260 + c8); const f32x4 z0 = zp[0], z1 = zp[1];
                u32x4 o; o.x = cvtpk(bflo(uu.x) * z0.x, bfhi(uu.x) * z0.y); o.y = cvtpk(bflo(uu.y) * z0.z, bfhi(uu.y) * z0.w);
                o.z = cvtpk(bflo(uu.z) * z1.x, bfhi(uu.z) * z1.y); o.w = cvtpk(bflo(uu.w) * z1.z, bfhi(uu.w) * z1.w);
                if (!dummy) *(GAS u32x4*)up = o; }
            __syncthreads();
        }
    }
}

DI void attn_unit(int bh, int qb, int nbh, int nqb, u32x4 (&qraw)[4], bf16x8 (&kf)[4], bf16x8 (&vl)[2][2], const GAS bf16_t* Qf, const GAS bf16_t* Kn, const GAS bf16_t* Vt, GAS bf16_t* O, LAS unsigned char* wl, int lane) {
    const int ql = lane & 31, hi = lane >> 5;
    const GAS bf16_t* kbase = Kn + (size_t)bh * (SEQ / 32) * 2048 + lane * 8;
    const GAS bf16_t* vbase = Vt + (size_t)bh * (SEQ / 32) * 2048 + lane * 8;
    bf16x8 kn[4], vn[2][2];
    { const int j1 = qb > 0 ? qb - 1 : 0;
#pragma unroll
      for (int d0 = 0; d0 < 4; ++d0) kn[d0] = *(const GAS bf16x8*)(kbase + (j1 * 4 + d0) * 512);
#pragma unroll
      for (int dh = 0; dh < 2; ++dh)
#pragma unroll
          for (int m = 0; m < 2; ++m) vn[dh][m] = *(const GAS bf16x8*)(vbase + (j1 * 4 + dh * 2 + m) * 512); }
    u32x4 qn[4]; bf16x8 kfn[4], vln[2][2];
#pragma unroll
    for (int d0 = 0; d0 < 4; ++d0) { qn[d0] = *(const GAS u32x4*)(Qf + ((size_t)(nbh * (SEQ / 32) + nqb) * 4 + d0) * 512 + lane * 8);
        kfn[d0] = *(const GAS bf16x8*)(Kn + ((size_t)(nbh * (SEQ / 32) + nqb) * 4 + d0) * 512 + lane * 8); }
#pragma unroll
    for (int dh = 0; dh < 2; ++dh)
#pragma unroll
        for (int m = 0; m < 2; ++m) vln[dh][m] = *(const GAS bf16x8*)(Vt + ((size_t)(nbh * (SEQ / 32) + nqb) * 4 + dh * 2 + m) * 512 + lane * 8);
    __builtin_amdgcn_sched_barrier(0);
    bf16x8 qr[4];
    {
        float ss = 0.f;
#pragma unroll
        for (int d0 = 0; d0 < 4; ++d0) {
            const float f0 = bflo(qraw[d0].x), f1 = bfhi(qraw[d0].x), f2 = bflo(qraw[d0].y), f3 = bfhi(qraw[d0].y), f4 = bflo(qraw[d0].z), f5 = bfhi(qraw[d0].z), f6 = bflo(qraw[d0].w), f7 = bfhi(qraw[d0].w);
            ss += (f0 * f0 + f1 * f1) + (f2 * f2 + f3 * f3) + (f4 * f4 + f5 * f5) + (f6 * f6 + f7 * f7); }
        ss += __shfl_xor(ss, 32);
        const float scl = rsqrtf(ss * (1.f / HD) + EPS) * (0.125f * LOG2E);
#pragma unroll
        for (int d0 = 0; d0 < 4; ++d0) { const LAS float* qg = (const LAS float*)(wl + 4608); const f32x4 g0 = *(const LAS f32x4*)(qg + d0 * 16 + hi * 8), g1 = *(const LAS f32x4*)(qg + d0 * 16 + hi * 8 + 4);
            u32x4 w; w.x = cvtpk(bflo(qraw[d0].x) * scl * g0.x, bfhi(qraw[d0].x) * scl * g0.y); w.y = cvtpk(bflo(qraw[d0].y) * scl * g0.z, bfhi(qraw[d0].y) * scl * g0.w);
            w.z = cvtpk(bflo(qraw[d0].z) * scl * g1.x, bfhi(qraw[d0].z) * scl * g1.y); w.w = cvtpk(bflo(qraw[d0].w) * scl * g1.z, bfhi(qraw[d0].w) * scl * g1.w);
            qr[d0] = __builtin_bit_cast(bf16x8, w); }
    }
    f32x16 o0, o1;
#pragma unroll
    for (int r = 0; r < 16; ++r) { o0[r] = 0.f; o1[r] = 0.f; }
    float carry = 0.f;
    for (int j = qb; j >= 0; --j) {
        f32x16 p;
#pragma unroll
        for (int r = 0; r < 16; ++r) p[r] = 0.f;
#pragma unroll
        for (int d0 = 0; d0 < 4; ++d0) p = __builtin_amdgcn_mfma_f32_32x32x16_bf16(kf[d0], qr[d0], p, 0, 0, 0);
        const int lim = (j == qb) ? ql : 64;
        float lk[16], lb[16];
#pragma unroll
        for (int r = 0; r < 16; ++r) { const float z = __builtin_amdgcn_fmed3f(p[r], -120.0f, 120.0f); const float sp = __builtin_amdgcn_logf(1.0f + __builtin_amdgcn_exp2f(z));
            const bool valid = ((r & 3) + 8 * (r >> 2) + 4 * hi) < lim;
            lk[r] = valid ? -sp : 0.f; lb[r] = valid ? (z - sp) : -1.0e30f; }
        float T[4], To[4], suf[16];
#pragma unroll
        for (int g = 0; g < 4; ++g) { suf[4 * g + 3] = 0.f; suf[4 * g + 2] = lk[4 * g + 3]; suf[4 * g + 1] = suf[4 * g + 2] + lk[4 * g + 2]; suf[4 * g] = suf[4 * g + 1] + lk[4 * g + 1]; T[g] = suf[4 * g] + lk[4 * g]; }
#pragma unroll
        for (int g = 0; g < 4; ++g) To[g] = __shfl_xor(T[g], 32);
        float run = carry, off[4];
#pragma unroll
        for (int g = 3; g >= 0; --g) { off[g] = run + (hi == 0 ? To[g] : 0.f); run += T[g] + To[g]; }
        float w[16];
#pragma unroll
        for (int r = 0; r < 16; ++r) w[r] = __builtin_amdgcn_exp2f(lb[r] + (off[r >> 2] + suf[r]));
        bf16x8 pf[2];
#pragma unroll
        for (int m = 0; m < 2; ++m) { u32x4 t; t.x = cvtpk(w[8 * m], w[8 * m + 1]); t.y = cvtpk(w[8 * m + 2], w[8 * m + 3]); t.z = cvtpk(w[8 * m + 4], w[8 * m + 5]); t.w = cvtpk(w[8 * m + 6], w[8 * m + 7]); pf[m] = __builtin_bit_cast(bf16x8, t); }
#pragma unroll
        for (int m = 0; m < 2; ++m) {
            o0 = __builtin_amdgcn_mfma_f32_32x32x16_bf16(vl[0][m], pf[m], o0, 0, 0, 0);
            o1 = __builtin_amdgcn_mfma_f32_32x32x16_bf16(vl[1][m], pf[m], o1, 0, 0, 0);
        }
        carry = run;
        if (__builtin_amdgcn_ballot_w64(carry >= CARRY_STOP) == 0ull) break;
        __builtin_amdgcn_sched_barrier(0);
        asm volatile("" : "+v"(kn[0]), "+v"(kn[1]), "+v"(kn[2]), "+v"(kn[3]));
        asm volatile("" : "+v"(vn[0][0]), "+v"(vn[0][1]), "+v"(vn[1][0]), "+v"(vn[1][1]));
#pragma unroll
        for (int d0 = 0; d0 < 4; ++d0) kf[d0] = kn[d0];
#pragma unroll
        for (int dh = 0; dh < 2; ++dh)
#pragma unroll
            for (int m = 0; m < 2; ++m) vl[dh][m] = vn[dh][m];
        { const int j2 = j > 2 ? j - 2 : 0;
#pragma unroll
          for (int d0 = 0; d0 < 4; ++d0) kn[d0] = *(const GAS bf16x8*)(kbase + (j2 * 4 + d0) * 512);
#pragma unroll
          for (int dh = 0; dh < 2; ++dh)
#pragma unroll
              for (int m = 0; m < 2; ++m) vn[dh][m] = *(const GAS bf16x8*)(vbase + (j2 * 4 + dh * 2 + m) * 512); }
        __builtin_amdgcn_sched_barrier(0);
    }
    {
        LAS bf16_t* tl = (LAS bf16_t*)wl;
#pragma unroll
        for (int g = 0; g < 4; ++g) {
            u32x2 w0; w0.x = cvtpk(o0[4 * g], o0[4 * g + 1]); w0.y = cvtpk(o0[4 * g + 2], o0[4 * g + 3]); *(LAS u32x2*)(tl + ql * 72 + 8 * g + 4 * hi) = w0;
            u32x2 w1; w1.x = cvtpk(o1[4 * g], o1[4 * g + 1]); w1.y = cvtpk(o1[4 * g + 2], o1[4 * g + 3]); *(LAS u32x2*)(tl + ql * 72 + 32 + 8 * g + 4 * hi) = w1;
        }
        asm volatile("s_waitcnt lgkmcnt(0)" ::: "memory");
        GAS bf16_t* op = O + ((size_t)(bh >> 4) * SEQ + (size_t)qb * 32) * DM + (bh & 15) * HD;
#pragma unroll
        for (int i = 0; i < 4; ++i) { const int row = i * 8 + (lane >> 3), ch = lane & 7; const u32x4 v = *(const LAS u32x4*)(tl + row * 72 + ch * 8); *(GAS u32x4*)(op + (size_t)row * DM + ch * 8) = v; }
        asm volatile("s_waitcnt lgkmcnt(0)" ::: "memory");
    }
    __builtin_amdgcn_sched_barrier(0);
    asm volatile("" : "+v"(qn[0]), "+v"(qn[1]), "+v"(qn[2]), "+v"(qn[3]));
    asm volatile("" : "+v"(kfn[0]), "+v"(kfn[1]), "+v"(kfn[2]), "+v"(kfn[3]));
    asm volatile("" : "+v"(vln[0][0]), "+v"(vln[0][1]), "+v"(vln[1][0]), "+v"(vln[1][1]));
#pragma unroll
    for (int d0 = 0; d0 < 4; ++d0) { qraw[d0] = qn[d0]; kf[d0] = kfn[d0]; }
#pragma unroll
    for (int dh = 0; dh < 2; ++dh)
#pragma unroll
        for (int m = 0; m < 2; ++m) vl[dh][m] = vln[dh][m];
}
DI void attn_phase(LAS unsigned char* lds, const bf16_t* Qf_, const bf16_t* Kn_, const bf16_t* Vt_, bf16_t* O_, const float* qg_, int wave, int lane, int G, int vcu) {
    const GAS bf16_t* Qf = (const GAS bf16_t*)Qf_; const GAS bf16_t* Kn = (const GAS bf16_t*)Kn_; const GAS bf16_t* Vt = (const GAS bf16_t*)Vt_;
    const int gw = vcu * 8 + wave, NGW = G * 8, NU = BATCH * NH * (SEQ / 32);
    LAS unsigned char* wl = lds + wave * 8192;
    ((LAS float*)(wl + 4608))[lane] = ((const GAS float*)qg_)[lane];
    asm volatile("s_waitcnt vmcnt(0) lgkmcnt(0)" ::: "memory");
    int u = gw; if (u >= NU) return;
#if ATTN_SKEW
    if (wave >= 4) __builtin_amdgcn_s_sleep(ATTN_SKEW);
#endif
    u32x4 qraw[4]; bf16x8 kf[4], vl[2][2];
#pragma unroll
    for (int d0 = 0; d0 < 4; ++d0) { qraw[d0] = *(const GAS u32x4*)(Qf + ((size_t)u * 4 + d0) * 512 + lane * 8); kf[d0] = *(const GAS bf16x8*)(Kn + ((size_t)u * 4 + d0) * 512 + lane * 8); }
#pragma unroll
    for (int dh = 0; dh < 2; ++dh)
#pragma unroll
        for (int m = 0; m < 2; ++m) vl[dh][m] = *(const GAS bf16x8*)(Vt + ((size_t)u * 4 + dh * 2 + m) * 512 + lane * 8);
    for (; u < NU; u += NGW) { const int un = (u + NGW < NU) ? u + NGW : u;
        attn_unit(u >> 7, u & 127, un >> 7, un & 127, qraw, kf, vl, Qf, Kn, Vt, (GAS bf16_t*)O_, wl, lane); }
}

#define XB_TMO      128
#define XB_XCNT(j)  (256  + 64 * (j))
#define XB_XSUB(j)  (1280 + 64 * (j))
#define XB_XGEN(j)  (2304 + 64 * (j))
#define XB_TOP      3328
#define XB_TOPGEN   3392
#define XCD_BAR_WORDS 3456
#define XB_SPIN_CAP (1u << 20)
DI unsigned xb_ld(unsigned* p)              { return __hip_atomic_load(p, __ATOMIC_RELAXED, __HIP_MEMORY_SCOPE_AGENT); }
DI unsigned xb_add(unsigned* p, unsigned v) { return __hip_atomic_fetch_add(p, v, __ATOMIC_RELAXED, __HIP_MEMORY_SCOPE_AGENT); }
DI unsigned xb_xcc_id() { return (unsigned)__builtin_amdgcn_s_getreg((3 << 11) | 20) & 0xFu; }
#define XB_SPIN(cond, bar) do { unsigned _sp = 0; while (cond) { \
    if ((++_sp & 255u) == 0u) { if (xb_ld(&(bar)[XB_TMO])) break; if (_sp > XB_SPIN_CAP) { atomicAdd(&(bar)[XB_TMO], 1u); break; } } } } while (0)
struct XcdBarrier { unsigned* bar; unsigned x; volatile LAS unsigned* st; };
DI void xcd_barrier_complete(unsigned* bar, unsigned x, unsigned& nloc, unsigned& nx) {
    const unsigned G = gridDim.x * gridDim.y * gridDim.z;
    unsigned sum, cnt, mine, sp = 0u;
    for (;;) {
        sum = 0u; cnt = 0u; mine = 0u;
#pragma unroll
        for (unsigned j = 0; j < 16; ++j) { const unsigned c = xb_ld(&bar[XB_XCNT(j)]); sum += c; cnt += (c > 0u) ? 1u : 0u; mine = (j == x) ? c : mine; }
        if (sum == G) break;
        __builtin_amdgcn_s_sleep(1);
        if ((++sp & 255u) == 0u) { if (xb_ld(&bar[XB_TMO])) break; if (sp > XB_SPIN_CAP) { atomicAdd(&bar[XB_TMO], 1u); break; } }
    }
    nloc = mine > 0u ? mine : 1u; nx = cnt > 0u ? cnt : 1u;
}
DI void xcd_barrier(const XcdBarrier& b) {
    asm volatile("s_waitcnt vmcnt(0)" ::: "memory");
    __syncthreads();
    if (threadIdx.x == 0) {
        unsigned* bar = b.bar;
        __builtin_amdgcn_s_waitcnt(0);
        unsigned nloc = b.st[0], nx = b.st[1];
        if (nloc == 0u) { xcd_barrier_complete(bar, b.x, nloc, nx); b.st[0] = nloc; b.st[1] = nx; }
        const unsigned old = xb_add(&bar[XB_XSUB(b.x)], 1u);
        const unsigned gen = old / nloc;
        if (old + 1u == (gen + 1u) * nloc) {
            __builtin_amdgcn_fence(__ATOMIC_RELEASE, "agent");
            asm volatile("s_waitcnt vmcnt(0)" ::: "memory");
            const unsigned og = xb_add(&bar[XB_TOP], 1u);
            const unsigned tg = og / nx;
            if (og + 1u == (tg + 1u) * nx) xb_add(&bar[XB_TOPGEN], 1u);
            else XB_SPIN(xb_ld(&bar[XB_TOPGEN]) == tg, bar);
            __builtin_amdgcn_fence(__ATOMIC_ACQUIRE, "agent");
            xb_add(&bar[XB_XGEN(b.x)], 1u);
            asm volatile("s_waitcnt vmcnt(0)" ::: "memory");
        } else {
            XB_SPIN(xb_ld(&bar[XB_XGEN(b.x)]) == gen, bar);
            __builtin_amdgcn_fence(__ATOMIC_ACQUIRE, "agent");
            asm volatile("s_waitcnt vmcnt(0)" ::: "memory");
        }
    }
    __syncthreads();
}

enum { PI_X = 0, PI_C, PI_MODW, PI_MODB, PI_NORMG, PI_WUP, PI_WDN, PI_AWIN, PI_AVG, PI_AWS, PI_ABS, PI_AWOUT, PI_KVMODW, PI_KVMODB, PI_KVNORMG, PI_KVW, PI_KNORMG, PI_BWQ, PI_QNORMG, PI_BWOUT, PI_OUT, PI_WS, PI_N };
constexpr int PTAB_OFF = LDS_BYTES - 512, XBST_OFF = LDS_BYTES - 64;
template <class T> DI T* ldp(int i) {
    extern __shared__ __attribute__((aligned(16))) unsigned char lds_raw[];
    const LAS unsigned* t = (const LAS unsigned*)((LAS unsigned char*)lds_raw + PTAB_OFF) + 2 * i;
    const unsigned lo = __builtin_amdgcn_readfirstlane(t[0]), hi = __builtin_amdgcn_readfirstlane(t[1]);
    return (T*)(((unsigned long long)hi << 32) | (unsigned long long)lo);
}
__global__ void __launch_bounds__(NTHREADS, 2) yoco_fwd(Params p) {
    extern __shared__ __attribute__((aligned(16))) unsigned char lds_raw[];
    LAS unsigned char* lds = (LAS unsigned char*)lds_raw;
    cg::grid_group grid = cg::this_grid();
    using pg8::Gemm; using pg8::StaticOrder; using pg8::EpiAct; using pg8::EpiRes; using pg8::gemm_phase;
    {
        LAS unsigned long long* pt = (LAS unsigned long long*)(lds + PTAB_OFF);
        if (threadIdx.x < 2) ((LAS unsigned*)(lds + XBST_OFF))[threadIdx.x] = 0u;
        if (threadIdx.x == 0) (void)xb_add((unsigned*)p.ws + XB_XCNT(xb_xcc_id()), 1u);
        if (threadIdx.x == 0) {
            const float* const* src = (const float* const*)&p;
#pragma unroll
            for (int i = 0; i < PI_N; ++i) pt[i] = (unsigned long long)src[i];
        }
        __syncthreads();
        const int tid = threadIdx.x, lane = tid & 63, wave = __builtin_amdgcn_readfirstlane(tid >> 6);
        Params q;
        q.x = ldp<const float>(PI_X); q.c = ldp<const float>(PI_C); q.mod_w = ldp<const float>(PI_MODW); q.mod_b = ldp<const float>(PI_MODB); q.norm_g = nullptr;
        q.w_up = ldp<const float>(PI_WUP); q.w_down = ldp<const float>(PI_WDN); q.a_w_in = ldp<const float>(PI_AWIN); q.a_vg = nullptr; q.a_ws = nullptr; q.a_bs = nullptr;
        q.a_w_out = ldp<const float>(PI_AWOUT); q.kv_mod_w = ldp<const float>(PI_KVMODW); q.kv_mod_b = ldp<const float>(PI_KVMODB); q.kv_norm_g = nullptr; q.kv_w = ldp<const float>(PI_KVW);
        q.k_norm_g = nullptr; q.b_w_q = ldp<const float>(PI_BWQ); q.q_norm_g = nullptr; q.b_w_out = ldp<const float>(PI_BWOUT); q.out = nullptr; q.ws = ldp<unsigned char>(PI_WS);
        for (int rep = 0; rep < REP_P0; ++rep) { p0_phase(q, lds, tid, wave, lane, gridDim.x, blockIdx.x); __syncthreads(); }
    }
    if (gridDim.x == 0x7fffffffu) grid.sync();
    { XcdBarrier xb; xb.bar = (unsigned*)ldp<unsigned char>(PI_WS); xb.x = xb_xcc_id(); xb.st = (volatile LAS unsigned*)(lds + XBST_OFF); xcd_barrier(xb); }

    for (int layer = 0; layer < 4; ++layer) {
        for (int step = 0; step < 12; ++step) {
            if (step >= 9 && layer != 1) break;
            if (step == 7 || step == 8 || step == 11) continue;
            if (step == 0 && layer == 2) continue;
            int tid = threadIdx.x; asm volatile("" : "+v"(tid));
            const int lane = tid & 63, wave = __builtin_amdgcn_readfirstlane(tid >> 6);
            int bid = blockIdx.x; asm volatile("" : "+s"(bid));
            const int G = gridDim.x;
            unsigned char* ws = ldp<unsigned char>(PI_WS);
            float* outp = ldp<float>(PI_OUT);
            const float* xcur = (layer == 0 && step <= 3) ? ldp<const float>(PI_X) : outp;
            float* MOD = (float*)(ws + WS_MOD);
            const float* modl = MOD + (size_t)layer * 8 * MODS;
            bf16_t* XN = (bf16_t*)(ws + WS_XN);
            const bool lo = layer < 2; const int j = layer & 1;
            if (step == 0 || step == 4 || step == 9) {
                const float* gn = step == 9 ? ldp<const float>(PI_KVNORMG) : ldp<const float>(PI_NORMG) + (layer * 2 + (step == 4 ? 1 : 0)) * DM;
                const float* mv = step == 9 ? MOD + (size_t)4 * 8 * MODS : modl + (step == 4 ? 3 * DM : 0);
                for (int rep = 0; rep < REP_NORM; ++rep)
                if (step == 0 && layer == 2 && rep == 0) norm_phase<true>(xcur, gn, mv, mv + DM, XN, nullptr, nullptr, nullptr, nullptr, true, (const bf16_t*)(ws + WS_KR), ldp<const float>(PI_KNORMG), (bf16_t*)(ws + WS_KF), (const bf16_t*)(ws + WS_VT), (bf16_t*)(ws + WS_VF), wave, lane, G, bid);
                else if (step == 9) norm_phase<false>(xcur, gn, mv, mv + DM, XN, ldp<const float>(PI_NORMG) + 4 * DM, MOD + (size_t)2 * 8 * MODS, MOD + (size_t)2 * 8 * MODS + DM, (bf16_t*)(ws + WS_XN2), false, nullptr, nullptr, nullptr, nullptr, nullptr, wave, lane, G, bid);
                else norm_phase<false>(xcur, gn, mv, mv + DM, XN, nullptr, nullptr, nullptr, nullptr, false, nullptr, nullptr, nullptr, nullptr, nullptr, wave, lane, G, bid);
            } else if (step == 1 || step == 5 || step == 10) {
                Gemm g; EpiAct E;
                if (step == 1) {
                    if (lo) { g = Gemm{XN, (const bf16_t*)(ws + WS_WIN) + (size_t)j * DM * 2 * GW, MTOK, 2 * GW, DM, DM, DM}; E = EpiAct{(bf16_t*)(ws + WS_UV), UVP, 1, (float*)(ws + WS_SSQ), 8, 0}; }
                    else    { g = Gemm{layer == 2 ? (const bf16_t*)(ws + WS_XN2) : (const bf16_t*)XN, (const bf16_t*)(ws + WS_WQ) + (size_t)j * DM * DM, MTOK, DM, DM, DM, DM}; E = EpiAct{(bf16_t*)(ws + WS_Q), DM, 0, nullptr, 0, 1}; }
                } else if (step == 5) {
                    g = Gemm{XN, (const bf16_t*)(ws + ws_up(layer)), MTOK, DFF, DM, DM, DM}; E = EpiAct{(bf16_t*)(ws + WS_H), HP, 2, nullptr, 0, 0};
                }
                const int nparts = (step == 10) ? 2 : 1;
                for (int part = 0; part < nparts; ++part) {
                if (step == 10) {
                    if (part == 0) { g = Gemm{XN, (const bf16_t*)(ws + WS_WKV), MTOK, DM, DM, DM, DM}; E = EpiAct{(bf16_t*)(ws + WS_KF), DM, 0, nullptr, 0, 1}; }
                    else { g = Gemm{(const bf16_t*)(ws + WS_WKV) + (size_t)DM * DM, XN, DM, MTOK, DM, DM, DM}; E = EpiAct{(bf16_t*)(ws + WS_VF), VTP, 0, nullptr, 0, 2}; }
                }
                StaticOrder S; S.init(g.M, g.N, G, bid);
#if STAGGER
                if (g.N >= 4096) { const int dly = ((bid >> 3) & 3) * STAGGER; for (int q = 0; q < dly; ++q) __builtin_amdgcn_s_sleep(127); }
#endif
                const int nrep = (step == 1 && lo) ? REP_G1 : (step == 5 ? REP_UP : REP_GACT);
                for (int rep = 0; rep < nrep; ++rep) gemm_phase<EpiAct, StaticOrder, true, true>(lds, g, S, E, tid);
                if (step == 10 && part == 0) { asm volatile("s_waitcnt vmcnt(0)" ::: "memory"); __syncthreads(); knorm_own_units((bf16_t*)(ws + WS_KF), ldp<const float>(PI_KNORMG), S, wave, lane); }
                }
            } else if (step == 3 || step == 6) {
                Gemm g; EpiRes E;
                if (step == 3) {
                    if (lo) g = Gemm{(const bf16_t*)(ws + WS_UV), (const bf16_t*)(ws + WS_WAO) + (size_t)j * GW * DM, MTOK, DM, GW, UVP, GW};
                    else    g = Gemm{(const bf16_t*)(ws + WS_O), (const bf16_t*)(ws + WS_WBO) + (size_t)j * DM * DM, MTOK, DM, DM, DM, DM};
                    E = EpiRes{xcur, outp, modl + 2 * DM, 0};
                } else {
                    g = Gemm{(const bf16_t*)(ws + WS_H), (const bf16_t*)(ws + ws_dn(layer)), MTOK, DM, DFF, HP, DFF}; E = EpiRes{xcur, outp, modl + 5 * DM, 0};
                }
                StaticOrder S; S.init(g.M, g.N, G, bid);
                gemm_phase<EpiRes, StaticOrder, true, true>(lds, g, S, E, tid);
            } else {
                if (lo) for (int rep = 0; rep < REP_SPAT; ++rep) spatial_phase(lds, (bf16_t*)(ws + WS_UV), (const float*)(ws + WS_SSQ), ldp<const float>(PI_AWS) + (size_t)j * 8 * 128 * 128, ldp<const float>(PI_ABS) + j * 8 * 128, ldp<const float>(PI_AVG) + j * GW, tid, wave, lane, G, bid, rep + 1 < REP_SPAT);
                else { const int vcu = (G % 8 == 0) ? (bid % 8) * (G / 8) + bid / 8 : bid;
                       for (int rep = 0; rep < REP_ATTN; ++rep) attn_phase(lds, (const bf16_t*)(ws + WS_Q), (const bf16_t*)(ws + WS_KF), (const bf16_t*)(ws + WS_VF), (bf16_t*)(ws + WS_O), ldp<const float>(PI_QNORMG) + j * HD, wave, lane, G, vcu); }
            }
            { XcdBarrier xb; xb.bar = (unsigned*)ldp<unsigned char>(PI_WS); xb.x = xb_xcc_id(); xb.st = (volatile LAS unsigned*)(lds + XBST_OFF);
              for (int rep = 0; rep < REP_SYNC; ++rep) xcd_barrier(xb); }
        }
    }
}

extern "C" void kernel_launch(void* const* d_in, const int* in_sizes, int n_in, void* d_out, int out_size, void* d_ws, size_t ws_size, hipStream_t stream) {
    static int grid = 0;
    if (grid == 0) {
        if (n_in != 20 || ws_size < WS_END) { fprintf(stderr, "kernel_launch: unexpected n_in %d / ws_size %zu\n", n_in, ws_size); grid = -1; return; }
        int dev = 0, cus = 0, per_cu = 0;
        (void)hipGetDevice(&dev);
        (void)hipDeviceGetAttribute(&cus, hipDeviceAttributeMultiprocessorCount, dev);
        if (hipFuncSetAttribute((const void*)yoco_fwd, hipFuncAttributeMaxDynamicSharedMemorySize, LDS_BYTES) != hipSuccess) { fprintf(stderr, "kernel_launch: hipFuncSetAttribute failed\n"); }
        if (hipOccupancyMaxActiveBlocksPerMultiprocessor(&per_cu, (const void*)yoco_fwd, NTHREADS, LDS_BYTES) != hipSuccess || per_cu < 1) { fprintf(stderr, "kernel_launch: occupancy query says %d\n", per_cu); per_cu = 1; }
        (void)hipGetLastError();
        grid = cus > 0 ? cus : 256;
    }
    if (grid < 0) return;
    if (hipMemsetAsync(d_ws, 0, 16384, stream) != hipSuccess) { fprintf(stderr, "kernel_launch: hipMemsetAsync failed\n"); return; }
    Params p{};
    const float** pp = (const float**)&p;
    for (int i = 0; i < 20; ++i) pp[i] = (const float*)d_in[i];
    p.out = (float*)d_out; p.ws = (unsigned char*)d_ws;
    void* args[] = {&p};
    hipError_t e = hipLaunchCooperativeKernel((const void*)yoco_fwd, dim3(grid), dim3(NTHREADS), args, LDS_BYTES, stream);
    if (e != hipSuccess) fprintf(stderr, "kernel_launch: cooperative launch failed: %s (grid %d)\n", hipGetErrorString(e), grid);
}
```

```cpp
#include <hip/hip_runtime.h>
#include <hip/hip_cooperative_groups.h>
#include <cstdio>
#include <cstdint>
namespace cg = cooperative_groups;

#define DI __device__ __forceinline__
#define LAS __attribute__((address_space(3)))
#define GAS __attribute__((address_space(1)))
typedef unsigned short bf16_t;
typedef short bf16x8 __attribute__((ext_vector_type(8)));
typedef float f32x4 __attribute__((ext_vector_type(4)));
typedef float f32x2 __attribute__((ext_vector_type(2)));
typedef float f32x16 __attribute__((ext_vector_type(16)));
typedef unsigned u32x4 __attribute__((ext_vector_type(4)));
typedef unsigned u32x2 __attribute__((ext_vector_type(2)));
typedef __bf16 bf16x2_t __attribute__((ext_vector_type(2)));

constexpr int DM = 1024, BATCH = 8, SEQ = 4096, MTOK = BATCH * SEQ, DFF = 4096, GW = 2048, NH = 16, HD = 64;
constexpr float EPS = 1e-6f;
constexpr float LOG2E = 1.4426950408889634f;
constexpr int MODS = 6 * DM;
constexpr int HP = DFF + 64, UVP = 2 * GW + 64;
constexpr int VTP = MTOK + 64;
constexpr float CARRY_STOP = -48.0f;

constexpr size_t MiB = 1u << 20;
constexpr size_t WS_MOD = 1 * MiB;
constexpr size_t WS_SSQ = 2 * MiB;
constexpr size_t WS_UP23 = 8 * MiB, WS_DN23 = 24 * MiB, WS_WQ = 40 * MiB, WS_WBO = 44 * MiB;
constexpr size_t WS_XN = 48 * MiB;
constexpr size_t WS_UP01 = 112 * MiB, WS_DN01 = 128 * MiB, WS_WIN = 144 * MiB, WS_WAO = 160 * MiB;
constexpr size_t WS_WKV = 500 * MiB;
constexpr size_t WS_UV = 172 * MiB;
constexpr size_t WS_H = 240 * MiB;
constexpr size_t WS_KR = 240 * MiB, WS_VT = 304 * MiB;
constexpr size_t WS_KF = 112 * MiB, WS_VF = 176 * MiB;
constexpr size_t WS_Q = 240 * MiB, WS_O = 304 * MiB, WS_END = 504 * MiB;
constexpr size_t WS_XN2 = 400 * MiB;
__host__ __device__ constexpr size_t ws_up(int l) { return l < 2 ? WS_UP01 + (size_t)l * 8 * MiB : WS_UP23 + (size_t)(l - 2) * 8 * MiB; }
__host__ __device__ constexpr size_t ws_dn(int l) { return l < 2 ? WS_DN01 + (size_t)l * 8 * MiB : WS_DN23 + (size_t)(l - 2) * 8 * MiB; }

#ifndef WT_AUX
#define WT_AUX 0
#endif
#ifndef STAGGER
#define STAGGER 0
#endif
#ifndef REP_SYNC
#define REP_SYNC 1
#endif
#ifndef REP_NORM
#define REP_NORM 1
#endif
#ifndef REP_ATTN
#define REP_ATTN 1
#endif
#ifndef REP_P0
#define REP_P0 1
#endif
#ifndef REP_SPAT
#define REP_SPAT 1
#endif
#ifndef REP_GRES
#define REP_GRES 1
#endif
#ifndef REP_G1
#define REP_G1 1
#endif
#ifndef REP_UP
#define REP_UP 1
#endif
#ifndef ATTN_SKEW
#define ATTN_SKEW 0
#endif
#ifndef REP_GACT
#define REP_GACT 1
#endif
constexpr int LDS_BYTES = 147456;
constexpr int NTHREADS = 512;

DI unsigned cvtpk(float lo, float hi) { f32x2 v = {lo, hi}; bf16x2_t b = __builtin_convertvector(v, bf16x2_t); return __builtin_bit_cast(unsigned, b); }
DI float bflo(unsigned u) { return __uint_as_float(u << 16); }
DI float bfhi(unsigned u) { return __uint_as_float(u & 0xffff0000u); }
DI float wave_sum(float v) {
#pragma unroll
    for (int o = 1; o < 64; o <<= 1) v += __shfl_xor(v, o);
    return v;
}

namespace pg8 {
constexpr int BM = 256, BK = 64, HALF = 128, HTB = HALF * BK * 2, STAGE_BYTES = 8 * HTB, NXCD = 8, WGM = 8;
__host__ __device__ __forceinline__ int lds_byte(int r, int c) { const int st = (r >> 4) * 2 + (c >> 5), rr = r & 15, cc = c & 31, ob = rr * 64 + cc * 2; return st * 1024 + (ob ^ (((ob >> 9) & 1) << 5)); }
__host__ __device__ __forceinline__ void stage_rc(int b, int& R, int& C) { const int st = b / 1024, sb = b % 1024, swz = sb ^ (((sb >> 9) & 1) << 5); R = (st >> 1) * 16 + swz / 64; C = (st & 1) * 32 + (swz % 64) / 2; }
__host__ __device__ __forceinline__ int perm32(int rho) { const int n = rho >> 4, i = rho & 15; return 8 * (i >> 2) + 4 * n + (i & 3); }

struct Unit { int pm, pn; };
struct Gemm { const bf16_t* A; const bf16_t* Bt; int M, N, K, lda, ldb; };

struct StaticOrder {
    int nM, nN, nwg, G, c;
    __host__ __device__ void init(int M, int N, int G_, int c_) { nM = M / BM; nN = N / BM; nwg = nM * nN; G = G_; c = c_; }
    __host__ __device__ bool next(int i, Unit& u) const {
        const long L = (long)i * G + c; if (L >= nwg) return false;
        int wgid = (int)L; { const int q = nwg / NXCD, r = nwg % NXCD, xcd = wgid % NXCD, off = wgid / NXCD; wgid = (xcd < r ? xcd * (q + 1) : r * (q + 1) + (xcd - r) * q) + off; }
        const int nig = WGM * nN, gid = wgid / nig, fm = gid * WGM, gsz = (nM - fm) < WGM ? (nM - fm) : WGM;
        u.pm = fm + ((wgid % nig) % gsz); u.pn = (wgid % nig) / gsz; return true;
    }
    __device__ __forceinline__ void a_ready(const Unit&) const {}
    __device__ __forceinline__ void done(const Unit&) const {}
};

__device__ __forceinline__ f32x2 gelu_pk(f32x2 v) {
    const f32x2 av = __builtin_elementwise_abs(v), d = av * 0.2316418882f + 1.0f;
    f32x2 t; t.x = __builtin_amdgcn_rcpf(d.x); t.y = __builtin_amdgcn_rcpf(d.y);
    f32x2 q = t * 0.5307027145f + (-0.7265760135f); q = q * t + 0.7107068705f; q = q * t + (-0.142248368f); q = q * t + 0.127414796f; q = q * t;
    const f32x2 s = (v * v) * (-0.72134752044f);
    f32x2 e; e.x = __builtin_amdgcn_exp2f(s.x); e.y = __builtin_amdgcn_exp2f(s.y);
    const f32x2 m = v * (q * e), r = v - m;
    f32x2 o; o.x = v.x < 0.f ? m.x : r.x; o.y = v.y < 0.f ? m.y : r.y; return o;
}

struct EpiAct {
    static constexpr bool PERM = true, AFTER_DRAIN = false;
    bf16_t* O; int ldc; int act; float* ssq; int ssq_pn0;
    int qfrag;
    __device__ __forceinline__ void operator()(const f32x4 (&acc)[2][2][4][2], const Unit& u, int wr, int wc, int fr, int fq) const {
        const int row0 = u.pm * BM + wr * 64 + fr; const int col0 = u.pn * BM + wc * 32 + 8 * fq;
        const bool do_ssq = (ssq != nullptr) && (u.pn >= ssq_pn0);
        const __amdgpu_buffer_rsrc_t rsrc = __builtin_amdgcn_make_buffer_rsrc((void*)O, 0, 0x7fffffff, 0x00020000);
#pragma unroll
        for (int ai = 0; ai < 2; ++ai)
#pragma unroll
            for (int m = 0; m < 4; ++m) { const int row = row0 + ai * HALF + m * 16; bf16_t* rowp = O + (size_t)row * ldc + col0; float ss = 0.f;
#pragma unroll
                for (int bj = 0; bj < 2; ++bj) { f32x4 v0 = acc[ai][bj][m][0], v1 = acc[ai][bj][m][1];
                    if (act == 1) { f32x2 a = gelu_pk((f32x2){v0[0], v0[1]}), b = gelu_pk((f32x2){v0[2], v0[3]}), c = gelu_pk((f32x2){v1[0], v1[1]}), d = gelu_pk((f32x2){v1[2], v1[3]});
                        v0 = (f32x4){a.x, a.y, b.x, b.y}; v1 = (f32x4){c.x, c.y, d.x, d.y}; }
                    else if (act == 2) { v0 = __builtin_elementwise_max(v0, (f32x4){0.f, 0.f, 0.f, 0.f}); v1 = __builtin_elementwise_max(v1, (f32x4){0.f, 0.f, 0.f, 0.f}); v0 = v0 * v0; v1 = v1 * v1; }
                    if (do_ssq) ss += (v0[0] * v0[0] + v0[1] * v0[1]) + (v0[2] * v0[2] + v0[3] * v0[3]) + (v1[0] * v1[0] + v1[1] * v1[1]) + (v1[2] * v1[2] + v1[3] * v1[3]);
                    u32x4 w; w.x = cvtpk(v0[0], v0[1]); w.y = cvtpk(v0[2], v0[3]); w.z = cvtpk(v1[0], v1[1]); w.w = cvtpk(v1[2], v1[3]);
                    bf16_t* dst = rowp + bj * HALF;
                    if (qfrag == 1) { const int col = col0 + bj * HALF; dst = O + (((((size_t)((row >> 12) * NH + (col >> 6)) * (SEQ / 32) + ((row & (SEQ - 1)) >> 5)) * 4 + ((col & 63) >> 4)) * 64 + ((col >> 3) & 1) * 32 + (row & 31)) * 8); }
                    if (qfrag == 2) {
                        const int col = col0 + bj * HALF, s = col & (SEQ - 1), kk = s & 31;
                        const size_t it = ((((size_t)((col >> 12) * NH + (row >> 6)) * (SEQ / 32) + (s >> 5)) * 2 + ((row >> 5) & 1)) * 2 + (kk >> 4));
                        const size_t e0 = (it * 64 + (row & 31)) * 8 + 4 * ((kk >> 3) & 1);
                        u32x2 lo2; lo2.x = w.x; lo2.y = w.y; u32x2 hi2; hi2.x = w.z; hi2.y = w.w;
                        __builtin_amdgcn_raw_buffer_store_b64(lo2, rsrc, (unsigned)(e0 * 2), 0, WT_AUX);
                        __builtin_amdgcn_raw_buffer_store_b64(hi2, rsrc, (unsigned)((e0 + 32 * 8) * 2), 0, WT_AUX);
                    } else
                    __builtin_amdgcn_raw_buffer_store_b128(w, rsrc, (unsigned)((size_t)(dst - O) * 2), 0, WT_AUX); }
                if (do_ssq) { ss += __shfl_xor(ss, 16); ss += __shfl_xor(ss, 32); if (fq == 0) ((GAS float*)ssq)[(size_t)((u.pn - ssq_pn0) * 4 + wc) * MTOK + row] = ss; }
            }
    }
};
struct EpiRes {
    static constexpr bool PERM = false, AFTER_DRAIN = false;
    const float* base; float* out; const float* gate; int rowoff;
    __device__ __forceinline__ void operator()(const f32x4 (&acc)[2][2][4][2], const Unit& u, int wr, int wc, int fr, int fq) const {
        const int row0 = rowoff + u.pm * BM + wr * 64 + fr; const int col0 = u.pn * BM + wc * 32 + 4 * fq;
        const GAS float* gp = (const GAS float*)gate + (size_t)((rowoff + u.pm * BM) >> 12) * MODS + col0; const GAS float* gbase = (const GAS float*)base;
        const __amdgpu_buffer_rsrc_t rsrc = __builtin_amdgcn_make_buffer_rsrc((void*)out, 0, 0x7fffffff, 0x00020000);
        f32x4 gv[2][2];
#pragma unroll
        for (int bj = 0; bj < 2; ++bj)
#pragma unroll
            for (int n = 0; n < 2; ++n) gv[bj][n] = *(const GAS f32x4*)(gp + bj * HALF + n * 16);
#pragma unroll
        for (int ai = 0; ai < 2; ++ai) {
            f32x4 bs[4][2][2];
#pragma unroll
            for (int m = 0; m < 4; ++m) { const size_t off = (size_t)(row0 + ai * HALF + m * 16) * DM + col0;
#pragma unroll
                for (int bj = 0; bj < 2; ++bj)
#pragma unroll
                    for (int n = 0; n < 2; ++n) bs[m][bj][n] = *(const GAS f32x4*)(gbase + off + bj * HALF + n * 16); }
#pragma unroll
            for (int m = 0; m < 4; ++m) { const size_t off = (size_t)(row0 + ai * HALF + m * 16) * DM + col0;
#pragma unroll
                for (int bj = 0; bj < 2; ++bj)
#pragma unroll
                    for (int n = 0; n < 2; ++n) { const f32x4 o = bs[m][bj][n] + gv[bj][n] * acc[ai][bj][m][n]; __builtin_amdgcn_raw_buffer_store_b128(__builtin_bit_cast(u32x4, o), rsrc, (unsigned)((off + bj * HALF + n * 16) * 4), 0, WT_AUX); } }
        }
    }
};

template <class Epi, class Sched, bool ALIGN_EPI = false, bool SP2 = false>
__device__ __forceinline__ void gemm_phase(LAS unsigned char* lds, const Gemm g, const Sched& S, const Epi& E, const int tid) {
    const int wid = __builtin_amdgcn_readfirstlane(tid >> 6), lane = tid & 63, wr = wid >> 2, wc = wid & 3, fr = lane & 15, fq = lane >> 4;
    const int K = g.K, nt = K / BK;
    unsigned voffA[2], voffB[2];
#pragma unroll
    for (int i = 0; i < 2; ++i) { int R, C; stage_rc(tid * 16 + i * 8192, R, C); const int Rb = Epi::PERM ? ((R & ~31) + perm32(R & 31)) : R;
        voffA[i] = (unsigned)(R * g.lda + C) * 2u; voffB[i] = (unsigned)(Rb * g.ldb + C) * 2u; }
    const size_t kstep = (size_t)(BK * 2);
    const size_t hstepA = (size_t)HALF * g.lda * 2, hstepB = (size_t)HALF * g.ldb * 2;
    const size_t tstepA = 2 * hstepA, tstepB = 2 * hstepB;
    const unsigned ldsw = (unsigned)wid * 1024u;
    const int aoff = lds_byte(wr * 64 + fr, fq * 8), boff = lds_byte(wc * 32 + fr, fq * 8);
#define PG8_SA(b, h) (((b) * 2 + (h)) * HTB)
#define PG8_SB(b, h) ((4 + (b) * 2 + (h)) * HTB)
#define PG8_STAGE(bufoff, gbase, voff) do { _Pragma("unroll") for (int _i = 0; _i < 2; ++_i) \
        __builtin_amdgcn_global_load_lds((const unsigned*)((const char*)(gbase) + (voff)[_i]), (LAS unsigned*)(lds + (bufoff) + ldsw + _i * 8192), 16, 0, 0); } while (0)
#define PG8_LDA(dst, b, h) do { _Pragma("unroll") for (int m = 0; m < 4; ++m) _Pragma("unroll") for (int k = 0; k < 2; ++k) dst[m][k] = *(const LAS bf16x8*)(lds + PG8_SA(b, h) + aoff + m * 2048 + k * 1024); } while (0)
#define PG8_LDB(dst, b, h) do { _Pragma("unroll") for (int n = 0; n < 2; ++n) _Pragma("unroll") for (int k = 0; k < 2; ++k) dst[n][k] = *(const LAS bf16x8*)(lds + PG8_SB(b, h) + boff + n * 2048 + k * 1024); } while (0)
#define PG8_MMA(ai, bj, At, Bt) do { __builtin_amdgcn_s_setprio(1); _Pragma("unroll") for (int m = 0; m < 4; ++m) _Pragma("unroll") for (int n = 0; n < 2; ++n) _Pragma("unroll") for (int k = 0; k < 2; ++k) \
        acc[ai][bj][m][n] = __builtin_amdgcn_mfma_f32_16x16x32_bf16(Bt[n][k], At[m][k], acc[ai][bj][m][n], 0, 0, 0); __builtin_amdgcn_s_setprio(0); } while (0)
#define PG8_WAIT_V(n) asm volatile("s_waitcnt vmcnt(" #n ")" ::: "memory")
#define PG8_WAIT_L(n) asm volatile("s_waitcnt lgkmcnt(" #n ")" ::: "memory")
#define PG8_BAR __builtin_amdgcn_s_barrier()
#define PG8_SCHED __builtin_amdgcn_sched_barrier(0)
    Unit cur, nxt; int ui = 0;
    if (!S.next(0, cur)) return;
    f32x4 acc[2][2][4][2];
#pragma unroll
    for (int a = 0; a < 2; ++a)
#pragma unroll
        for (int b = 0; b < 2; ++b)
#pragma unroll
            for (int m = 0; m < 4; ++m)
#pragma unroll
                for (int n = 0; n < 2; ++n) acc[a][b][m][n] = (f32x4){0.f, 0.f, 0.f, 0.f};
    bf16x8 At[4][2], B0[2][2], B1[2][2];
    const char* cA = (const char*)g.A + (size_t)cur.pm * tstepA; const char* cB = (const char*)g.Bt + (size_t)cur.pn * tstepB;
    S.a_ready(cur);
    if constexpr (SP2) {
        PG8_STAGE(PG8_SB(0, 0), cB, voffB); PG8_STAGE(PG8_SB(0, 1), cB + hstepB, voffB); PG8_STAGE(PG8_SA(0, 0), cA, voffA); PG8_STAGE(PG8_SA(0, 1), cA + hstepA, voffA);
        if (wr == 1) PG8_BAR;
        PG8_WAIT_V(2); PG8_BAR;
        PG8_STAGE(PG8_SB(1, 0), cB + kstep, voffB); PG8_STAGE(PG8_SA(1, 0), cA + kstep, voffA); PG8_STAGE(PG8_SB(1, 1), cB + hstepB + kstep, voffB);
        PG8_WAIT_V(6); PG8_BAR;
    } else {
        PG8_STAGE(PG8_SB(0, 0), cB, voffB); PG8_STAGE(PG8_SA(0, 0), cA, voffA); PG8_STAGE(PG8_SB(0, 1), cB + hstepB, voffB); PG8_STAGE(PG8_SA(0, 1), cA + hstepA, voffA);
        if (wr == 1) PG8_BAR;
        PG8_WAIT_V(4); PG8_BAR;
        PG8_STAGE(PG8_SB(1, 0), cB + kstep, voffB); PG8_STAGE(PG8_SA(1, 0), cA + kstep, voffA); PG8_STAGE(PG8_SB(1, 1), cB + hstepB + kstep, voffB);
        PG8_WAIT_V(6); PG8_BAR;
    }
    for (;;) {
        const bool has_next = S.next(ui + 1, nxt);
        const char* nA = has_next ? (const char*)g.A + (size_t)nxt.pm * tstepA : cA; const char* nB = has_next ? (const char*)g.Bt + (size_t)nxt.pn * tstepB : cB;
        for (int t = 0; t < nt; t += 2) {
            const bool last = (t == nt - 2);
            const char* a1 = cA + (size_t)(t + 1) * kstep;
            const char* a2 = last ? nA : cA + (size_t)(t + 2) * kstep; const char* b2 = last ? nB : cB + (size_t)(t + 2) * kstep;
            const char* a3 = a2 + kstep; const char* b3 = b2 + kstep;
            if (last && has_next) S.a_ready(nxt);
            if constexpr (SP2) {
            PG8_LDB(B0, 0, 0); PG8_LDB(B1, 0, 1); PG8_SCHED; PG8_LDA(At, 0, 0); PG8_STAGE(PG8_SA(1, 1), a1 + hstepA, voffA);
            PG8_WAIT_V(8); PG8_WAIT_L(0); PG8_BAR; PG8_MMA(0, 0, At, B0); PG8_MMA(0, 1, At, B1); PG8_BAR; PG8_SCHED;
            PG8_LDA(At, 0, 1); PG8_STAGE(PG8_SB(0, 0), b2, voffB); PG8_STAGE(PG8_SB(0, 1), b2 + hstepB, voffB); PG8_STAGE(PG8_SA(0, 0), a2, voffA);
            PG8_WAIT_V(8); PG8_WAIT_L(0); PG8_BAR; PG8_MMA(1, 0, At, B0); PG8_MMA(1, 1, At, B1); PG8_BAR; PG8_SCHED;
            PG8_LDB(B0, 1, 0); PG8_LDB(B1, 1, 1); PG8_SCHED; PG8_LDA(At, 1, 0); PG8_STAGE(PG8_SA(0, 1), a2 + hstepA, voffA);
            PG8_WAIT_V(8); PG8_WAIT_L(0); PG8_BAR; PG8_MMA(0, 0, At, B0); PG8_MMA(0, 1, At, B1); PG8_BAR; PG8_SCHED;
            PG8_LDA(At, 1, 1); PG8_STAGE(PG8_SB(1, 0), b3, voffB); PG8_STAGE(PG8_SB(1, 1), b3 + hstepB, voffB); PG8_STAGE(PG8_SA(1, 0), a3, voffA);
            PG8_WAIT_V(8); PG8_WAIT_L(0); PG8_BAR; PG8_MMA(1, 0, At, B0); PG8_MMA(1, 1, At, B1); PG8_BAR; PG8_SCHED;
            } else {
            PG8_LDB(B0, 0, 0); PG8_SCHED; PG8_LDA(At, 0, 0); PG8_STAGE(PG8_SA(1, 1), a1 + hstepA, voffA);
            PG8_WAIT_L(8); PG8_BAR; PG8_WAIT_L(0); PG8_MMA(0, 0, At, B0); PG8_BAR; PG8_SCHED;
            PG8_LDB(B1, 0, 1); PG8_STAGE(PG8_SB(0, 0), b2, voffB);
            PG8_BAR; PG8_WAIT_L(0); PG8_MMA(0, 1, At, B1); PG8_BAR;
            PG8_LDA(At, 0, 1); PG8_STAGE(PG8_SA(0, 0), a2, voffA);
            PG8_BAR; PG8_WAIT_L(0); PG8_MMA(1, 0, At, B0); PG8_BAR; PG8_SCHED;
            PG8_STAGE(PG8_SB(0, 1), b2 + hstepB, voffB);
            PG8_WAIT_V(6); PG8_BAR; PG8_MMA(1, 1, At, B1); PG8_BAR;
            PG8_LDB(B0, 1, 0); PG8_SCHED; PG8_LDA(At, 1, 0); PG8_STAGE(PG8_SA(0, 1), a2 + hstepA, voffA);
            PG8_WAIT_L(8); PG8_BAR; PG8_WAIT_L(0); PG8_MMA(0, 0, At, B0); PG8_BAR; PG8_SCHED;
            PG8_LDB(B1, 1, 1); PG8_STAGE(PG8_SB(1, 0), b3, voffB);
            PG8_BAR; PG8_WAIT_L(0); PG8_MMA(0, 1, At, B1); PG8_BAR;
            PG8_LDA(At, 1, 1); PG8_STAGE(PG8_SA(1, 0), a3, voffA);
            PG8_BAR; PG8_WAIT_L(0); PG8_MMA(1, 0, At, B0); PG8_BAR; PG8_SCHED;
            PG8_STAGE(PG8_SB(1, 1), b3 + hstepB, voffB);
            PG8_WAIT_V(6); PG8_BAR; PG8_MMA(1, 1, At, B1); PG8_BAR;
            }
        }
        if constexpr (ALIGN_EPI) { if (wr == 0) PG8_BAR; }
        if constexpr (!Epi::AFTER_DRAIN) { E(acc, cur, wr, wc, fr, fq); S.done(cur); }
        if (!has_next) break;
#pragma unroll
        for (int a = 0; a < 2; ++a)
#pragma unroll
            for (int b = 0; b < 2; ++b)
#pragma unroll
                for (int m = 0; m < 4; ++m)
#pragma unroll
                    for (int n = 0; n < 2; ++n) acc[a][b][m][n] = (f32x4){0.f, 0.f, 0.f, 0.f};
        cur = nxt; cA = nA; cB = nB; ++ui;
        if constexpr (ALIGN_EPI) { if (wr == 1) PG8_BAR; }
    }
    PG8_WAIT_V(0);
    if constexpr (!ALIGN_EPI) { if (wr == 0) PG8_BAR; }
    PG8_BAR;
#undef PG8_SA
#undef PG8_SB
#undef PG8_STAGE
#undef PG8_LDA
#undef PG8_LDB
#undef PG8_MMA
#undef PG8_WAIT_V
#undef PG8_WAIT_L
#undef PG8_BAR
#undef PG8_SCHED
}
}

struct Params {
    const float *x, *c, *mod_w, *mod_b, *norm_g, *w_up, *w_down, *a_w_in, *a_vg, *a_ws, *a_bs, *a_w_out, *kv_mod_w, *kv_mod_b, *kv_norm_g, *kv_w, *k_norm_g, *b_w_q, *q_norm_g, *b_w_out;
    float* out; unsigned char* ws;
};

struct TrItem { const GAS float* W; GAS bf16_t* WT; int K, N, item; };
DI void tr_load(const TrItem& t, f32x4 (&v)[16], int lane) {
    const int nblk = t.N / 64, kb = t.item / nblk, nb = t.item % nblk, k0 = 64 * kb, n0 = 64 * nb;
    const GAS float* wp = t.W + (size_t)(k0 + (lane >> 4)) * t.N + n0 + (lane & 15) * 4;
#pragma unroll
    for (int i = 0; i < 16; ++i) v[i] = *(const GAS f32x4*)(wp + (size_t)(4 * i) * t.N);
}
DI void tr_finish(const TrItem& t, const f32x4 (&v)[16], LAS float* scr, int lane) {
    const int nblk = t.N / 64, kb = t.item / nblk, nb = t.item % nblk, k0 = 64 * kb, n0 = 64 * nb;
    LAS float* sp = scr + (lane >> 4) * 65 + (lane & 15) * 4;
#pragma unroll
    for (int i = 0; i < 16; ++i) { LAS float* d = sp + (4 * i) * 65; d[0] = v[i].x; d[1] = v[i].y; d[2] = v[i].z; d[3] = v[i].w; }
    asm volatile("s_waitcnt lgkmcnt(0)" ::: "memory");
    const int c = lane & 7;
#pragma unroll
    for (int j = 0; j < 8; ++j) { const int n = (lane >> 3) + 8 * j; const LAS float* s = scr + (8 * c) * 65 + n;
        u32x4 o; o.x = cvtpk(s[0 * 65], s[1 * 65]); o.y = cvtpk(s[2 * 65], s[3 * 65]); o.z = cvtpk(s[4 * 65], s[5 * 65]); o.w = cvtpk(s[6 * 65], s[7 * 65]);
        *(GAS u32x4*)(t.WT + (size_t)(n0 + n) * t.K + k0 + 8 * c) = o; }
    asm volatile("s_waitcnt lgkmcnt(0)" ::: "memory");
}
DI TrItem tr_decode(const Params& p, int r) {
    GAS unsigned char* wsw = (GAS unsigned char*)p.ws;
    if (r < 4096) { const int l = r >> 10; return TrItem{(const GAS float*)p.w_up + (size_t)l * DM * DFF, (GAS bf16_t*)(wsw + ws_up(l)), DM, DFF, r & 1023}; } r -= 4096;
    if (r < 4096) { const int l = r >> 10; return TrItem{(const GAS float*)p.w_down + (size_t)l * DM * DFF, (GAS bf16_t*)(wsw + ws_dn(l)), DFF, DM, r & 1023}; } r -= 4096;
    if (r < 2048) { const int l = r >> 10; return TrItem{(const GAS float*)p.a_w_in + (size_t)l * DM * 2 * GW, (GAS bf16_t*)(wsw + WS_WIN) + (size_t)l * DM * 2 * GW, DM, 2 * GW, r & 1023}; } r -= 2048;
    if (r < 1024) { const int l = r >> 9; return TrItem{(const GAS float*)p.a_w_out + (size_t)l * GW * DM, (GAS bf16_t*)(wsw + WS_WAO) + (size_t)l * GW * DM, GW, DM, r & 511}; } r -= 1024;
    if (r < 512) { return TrItem{(const GAS float*)p.kv_w, (GAS bf16_t*)(wsw + WS_WKV), DM, 2 * DM, r}; } r -= 512;
    if (r < 512) { const int l = r >> 8; return TrItem{(const GAS float*)p.b_w_q + (size_t)l * DM * DM, (GAS bf16_t*)(wsw + WS_WQ) + (size_t)l * DM * DM, DM, DM, r & 255}; } r -= 512;
    { const int l = r >> 8; return TrItem{(const GAS float*)p.b_w_out + (size_t)l * DM * DM, (GAS bf16_t*)(wsw + WS_WBO) + (size_t)l * DM * DM, DM, DM, r & 255}; }
}

DI void p0_phase(const Params& p, LAS unsigned char* lds, int tid, int wave, int lane, int G, int bid) {
    GAS float* MOD = (GAS float*)(p.ws + WS_MOD);
    LAS float* cs = (LAS float*)lds;
    LAS float* red = (LAS float*)(lds + 32768);
    for (int i = tid; i < 8 * DM; i += NTHREADS) { const int b = i >> 10, k = i & 1023; cs[k * 8 + b] = ((const GAS float*)p.c)[i]; }
    __syncthreads();
    for (int it = bid; it < 416; it += G) {
        const GAS float* W; const GAS float* bias; GAS float* outp; int ldw, n0;
        if (it < 384) { const int l = it / 96; n0 = (it % 96) * 64; W = (const GAS float*)p.mod_w + (size_t)l * DM * MODS; ldw = MODS; bias = (const GAS float*)p.mod_b + l * MODS; outp = MOD + (size_t)l * 8 * MODS; }
        else { n0 = (it - 384) * 64; W = (const GAS float*)p.kv_mod_w; ldw = 2 * DM; bias = (const GAS float*)p.kv_mod_b; outp = MOD + (size_t)4 * 8 * MODS; }
        const GAS float* wp = W + (size_t)(wave * 128) * ldw + n0 + lane;
        float a0 = 0.f, a1 = 0.f, a2 = 0.f, a3 = 0.f, a4 = 0.f, a5 = 0.f, a6 = 0.f, a7 = 0.f;
#pragma unroll 32
        for (int kk = 0; kk < 128; ++kk) { const float w = wp[(size_t)kk * ldw]; const LAS f32x4* cp = (const LAS f32x4*)(cs + (wave * 128 + kk) * 8); const f32x4 c0 = cp[0], c1 = cp[1];
            a0 += w * c0.x; a1 += w * c0.y; a2 += w * c0.z; a3 += w * c0.w; a4 += w * c1.x; a5 += w * c1.y; a6 += w * c1.z; a7 += w * c1.w; }
        LAS float* rp = red + wave * 512 + lane;
        rp[0] = a0; rp[64] = a1; rp[128] = a2; rp[192] = a3; rp[256] = a4; rp[320] = a5; rp[384] = a6; rp[448] = a7;
        __syncthreads();
        { const int b = tid >> 6; float s = bias[n0 + lane];
#pragma unroll
          for (int w = 0; w < 8; ++w) s += red[w * 512 + b * 64 + lane];
          outp[(size_t)b * MODS + n0 + lane] = s; }
        __syncthreads();
    }
    __syncthreads();
    LAS float* scr = (LAS float*)(lds + wave * 16640);
    const int gw = bid * 8 + wave, NGW = G * 8;
    if (gw < 12800) {
        TrItem cur = tr_decode(p, gw); f32x4 v[16]; tr_load(cur, v, lane);
        for (int it = gw; it < 12800; it += NGW) {
            const int itn = it + NGW < 12800 ? it + NGW : it;
            const TrItem nxt = tr_decode(p, itn); f32x4 vn[16]; tr_load(nxt, vn, lane);
            __builtin_amdgcn_sched_barrier(0);
            tr_finish(cur, v, scr, lane);
            cur = nxt;
#pragma unroll
            for (int i = 0; i < 16; ++i) v[i] = vn[i];
        }
    }
}

template <bool KNORM>
DI void norm_phase(const float* x_, const float* g_, const float* sh_, const float* sc_, bf16_t* XN_, const float* g2_, const float* sh2_, const float* sc2_, bf16_t* XN2_, bool skipx, const bf16_t* Kb_, const float* kg_, bf16_t* Kf_, const bf16_t* Vt_, bf16_t* Vf_, int wave, int lane, int G, int bid) {
    const GAS float* x = (const GAS float*)x_; const GAS float* g = (const GAS float*)g_; const GAS float* sh = (const GAS float*)sh_; const GAS float* sc = (const GAS float*)sc_; GAS bf16_t* XN = (GAS bf16_t*)XN_;
    const GAS bf16_t* Kb = (const GAS bf16_t*)Kb_; const GAS float* kg = (const GAS float*)kg_; GAS bf16_t* Kf = (GAS bf16_t*)Kf_; const GAS bf16_t* Vt = (const GAS bf16_t*)Vt_; GAS bf16_t* Vf = (GAS bf16_t*)Vf_;
    const GAS float* g2 = (const GAS float*)g2_; const GAS float* sh2 = (const GAS float*)sh2_; const GAS float* sc2 = (const GAS float*)sc2_; GAS bf16_t* XN2 = (GAS bf16_t*)XN2_;
    const bool dual = XN2_ != nullptr;
    const int gw = bid * 8 + wave, NGW = G * 8;
    for (int chunk = gw; chunk < MTOK / 16; chunk += NGW) {
      const int b = (chunk * 16) >> 12;
      f32x4 wm[4], hh[4], wm2[4], hh2[4];
#pragma unroll
      for (int j = 0; j < 4; ++j) { const int idx = 4 * lane + 256 * j;
          if (!skipx) { wm[j] = *(const GAS f32x4*)(g + idx) * (*(const GAS f32x4*)(sc + (size_t)b * MODS + idx) + 1.0f); hh[j] = *(const GAS f32x4*)(sh + (size_t)b * MODS + idx); }
          else { wm[j] = (f32x4){0.f, 0.f, 0.f, 0.f}; hh[j] = wm[j]; }
          if (dual) { wm2[j] = *(const GAS f32x4*)(g2 + idx) * (*(const GAS f32x4*)(sc2 + (size_t)b * MODS + idx) + 1.0f); hh2[j] = *(const GAS f32x4*)(sh2 + (size_t)b * MODS + idx); }
          else { wm2[j] = (f32x4){0.f, 0.f, 0.f, 0.f}; hh2[j] = wm2[j]; } }
#pragma unroll 1
      for (int half = skipx ? 4 : 0; half < 4; ++half) {
          f32x4 v[4][4];
#pragma unroll
          for (int r = 0; r < 4; ++r) { const GAS f32x4* xr = (const GAS f32x4*)(x + (size_t)(chunk * 16 + half * 4 + r) * DM) + lane;
#pragma unroll
              for (int j = 0; j < 4; ++j) v[r][j] = xr[64 * j]; }
          float rstd[4];
#pragma unroll
          for (int r = 0; r < 4; ++r) { float s = 0.f;
#pragma unroll
              for (int j = 0; j < 4; ++j) s += (v[r][j].x * v[r][j].x + v[r][j].y * v[r][j].y) + (v[r][j].z * v[r][j].z + v[r][j].w * v[r][j].w);
              rstd[r] = rsqrtf(wave_sum(s) * (1.f / DM) + EPS); }
#pragma unroll
          for (int r = 0; r < 4; ++r) { GAS u32x2* o8 = (GAS u32x2*)(XN + (size_t)(chunk * 16 + half * 4 + r) * DM) + lane;
#pragma unroll
              for (int j = 0; j < 4; ++j) { const f32x4 y = (v[r][j] * rstd[r]) * wm[j] + hh[j];
                  u32x2 w; w.x = cvtpk(y.x, y.y); w.y = cvtpk(y.z, y.w); o8[64 * j] = w; }
              if (dual) { GAS u32x2* p8 = (GAS u32x2*)(XN2 + (size_t)(chunk * 16 + half * 4 + r) * DM) + lane;
#pragma unroll
                  for (int j = 0; j < 4; ++j) { const f32x4 y = (v[r][j] * rstd[r]) * wm2[j] + hh2[j];
                      u32x2 w; w.x = cvtpk(y.x, y.y); w.y = cvtpk(y.z, y.w); p8[64 * j] = w; } } }
      }
      u32x4 kc0, kc1;
      if (KNORM) { const GAS u32x4* kp = (const GAS u32x4*)(Kb + (size_t)(chunk * 16) * DM + 16 * lane); kc0 = kp[0]; kc1 = kp[1]; }
      if (KNORM) for (int i = 0; i < 16; ++i) {
        const int row = chunk * 16 + i;
        u32x4 kn0, kn1;
        { const int rn = chunk * 16 + (i < 15 ? i + 1 : 15);
          const GAS u32x4* kp = (const GAS u32x4*)(Kb + (size_t)rn * DM + 16 * lane); kn0 = kp[0]; kn1 = kp[1]; }
        __builtin_amdgcn_sched_barrier(0);
        if (KNORM) {
            const u32x4 k0 = kc0, k1 = kc1;
            float f[16];
            f[0] = bflo(k0.x); f[1] = bfhi(k0.x); f[2] = bflo(k0.y); f[3] = bfhi(k0.y); f[4] = bflo(k0.z); f[5] = bfhi(k0.z); f[6] = bflo(k0.w); f[7] = bfhi(k0.w);
            f[8] = bflo(k1.x); f[9] = bfhi(k1.x); f[10] = bflo(k1.y); f[11] = bfhi(k1.y); f[12] = bflo(k1.z); f[13] = bfhi(k1.z); f[14] = bflo(k1.w); f[15] = bfhi(k1.w);
            float ss = 0.f;
#pragma unroll
            for (int e = 0; e < 16; ++e) ss += f[e] * f[e];
            ss += __shfl_xor(ss, 1); ss += __shfl_xor(ss, 2);
            const float kr = rsqrtf(ss * (1.f / HD) + EPS);
            const GAS float* kgp = kg + ((16 * lane) & 63);
#pragma unroll
            for (int e = 0; e < 16; ++e) f[e] = f[e] * kr * kgp[e];
            u32x4 o0, o1;
            o0.x = cvtpk(f[0], f[1]); o0.y = cvtpk(f[2], f[3]); o0.z = cvtpk(f[4], f[5]); o0.w = cvtpk(f[6], f[7]);
            o1.x = cvtpk(f[8], f[9]); o1.y = cvtpk(f[10], f[11]); o1.z = cvtpk(f[12], f[13]); o1.w = cvtpk(f[14], f[15]);
            const int s = row & (SEQ - 1), hh = lane >> 2, d0 = lane & 3;
            GAS bf16_t* dst = Kf + ((((size_t)(b * NH + hh) * (SEQ / 32) + (s >> 5)) * 4 + d0) * 64 + (s & 31)) * 8;
            *(GAS u32x4*)dst = o0; *(GAS u32x4*)(dst + 32 * 8) = o1;
            kc0 = kn0; kc1 = kn1;
        }
      }
    }
}

DI void knorm_own_units(bf16_t* Kf_, const float* kg_, const pg8::StaticOrder& S, int wave, int lane) {
    GAS bf16_t* Kf = (GAS bf16_t*)Kf_; const GAS float* kg = (const GAS float*)kg_;
    const int hi = lane >> 5;
    f32x4 gq[4][2];
#pragma unroll
    for (int d0 = 0; d0 < 4; ++d0) { gq[d0][0] = *(const GAS f32x4*)(kg + d0 * 16 + hi * 8); gq[d0][1] = *(const GAS f32x4*)(kg + d0 * 16 + hi * 8 + 4); }
    pg8::Unit un;
    for (int ui = 0; S.next(ui, un); ++ui) {
        const int b = un.pm >> 4, tile0 = (un.pm & 15) * 8, h0 = un.pn * 4;
#pragma unroll 1
        for (int pr = 0; pr < 2; ++pr) {
            u32x4 kq[2][4]; int its[2];
#pragma unroll
            for (int k = 0; k < 2; ++k) { const int idx = wave * 4 + pr * 2 + k; its[k] = ((b * NH + h0 + (idx >> 3)) * (SEQ / 32)) + tile0 + (idx & 7);
#pragma unroll
                for (int d0 = 0; d0 < 4; ++d0) kq[k][d0] = *(const GAS u32x4*)(Kf + ((size_t)its[k] * 4 + d0) * 512 + lane * 8); }
#pragma unroll
            for (int k = 0; k < 2; ++k) {
                float ss = 0.f;
#pragma unroll
                for (int d0 = 0; d0 < 4; ++d0) { const u32x4 q = kq[k][d0];
                    const float f0 = bflo(q.x), f1 = bfhi(q.x), f2 = bflo(q.y), f3 = bfhi(q.y), f4 = bflo(q.z), f5 = bfhi(q.z), f6 = bflo(q.w), f7 = bfhi(q.w);
                    ss += (f0 * f0 + f1 * f1) + (f2 * f2 + f3 * f3) + (f4 * f4 + f5 * f5) + (f6 * f6 + f7 * f7); }
                ss += __shfl_xor(ss, 32);
                const float kr = rsqrtf(ss * (1.f / HD) + EPS);
#pragma unroll
                for (int d0 = 0; d0 < 4; ++d0) { const u32x4 q = kq[k][d0]; const f32x4 g0 = gq[d0][0], g1 = gq[d0][1];
                    u32x4 w; w.x = cvtpk(bflo(q.x) * kr * g0.x, bfhi(q.x) * kr * g0.y); w.y = cvtpk(bflo(q.y) * kr * g0.z, bfhi(q.y) * kr * g0.w);
                    w.z = cvtpk(bflo(q.z) * kr * g1.x, bfhi(q.z) * kr * g1.y); w.w = cvtpk(bflo(q.w) * kr * g1.z, bfhi(q.w) * kr * g1.w);
                    *(GAS u32x4*)(Kf + ((size_t)its[k] * 4 + d0) * 512 + lane * 8) = w; } }
        }
    }
}

DI void spatial_phase(LAS unsigned char* lds, bf16_t* UV_, const float* ssq_, const float* Wsp_, const float* bsp_, const float* gvn_, int tid, int wave, int lane, int G, int bid, bool dummy) {
    GAS bf16_t* UV = (GAS bf16_t*)UV_; const GAS float* ssq = (const GAS float*)ssq_; const GAS float* Wsp = (const GAS float*)Wsp_; const GAS float* bsp = (const GAS float*)bsp_; const GAS float* gvn = (const GAS float*)gvn_;
    constexpr int PITCH = 136;
    LAS float* rs = (LAS float*)lds;
    LAS bf16_t* Wl = (LAS bf16_t*)(lds + 1024);
    LAS bf16_t* vT = (LAS bf16_t*)(lds + 1024 + 128 * PITCH * 2);
    const int ql = lane & 31, hi = lane >> 5;
    for (int it = bid; it < 2048; it += G) {
        const int g = it & 7, n = it >> 3;
        const size_t tok0 = (size_t)n * 128;
        if (tid < 128) { const GAS float* pp = ssq + tok0 + tid; float sq[32];
#pragma unroll
            for (int i = 0; i < 32; ++i) sq[i] = pp[(size_t)i * MTOK];
            float s = 0.f;
#pragma unroll
            for (int i = 0; i < 32; i += 4) s += (sq[i] + sq[i + 1]) + (sq[i + 2] + sq[i + 3]);
            rs[tid] = rsqrtf(s * (1.f / GW) + EPS); }
        __syncthreads();
#pragma unroll
        for (int i = 0; i < 4; ++i) { const int idx = i * NTHREADS + tid, t = idx >> 4, s8 = (idx & 15) * 8;
            const GAS float* wp = Wsp + ((size_t)g * 128 + t) * 128 + s8; const f32x4 a = *(const GAS f32x4*)wp, b = *(const GAS f32x4*)(wp + 4);
            const LAS f32x4* rp = (const LAS f32x4*)(rs + s8); const f32x4 r0 = rp[0], r1 = rp[1];
            float w[8] = {a.x * r0.x, a.y * r0.y, a.z * r0.z, a.w * r0.w, b.x * r1.x, b.y * r1.y, b.z * r1.z, b.w * r1.w};
#pragma unroll
            for (int e = 0; e < 8; ++e) w[e] = (s8 + e <= t) ? w[e] : 0.f;
            u32x4 o; o.x = cvtpk(w[0], w[1]); o.y = cvtpk(w[2], w[3]); o.z = cvtpk(w[4], w[5]); o.w = cvtpk(w[6], w[7]);
            *(LAS u32x4*)(Wl + t * PITCH + s8) = o; }
        u32x4 vq[8];
#pragma unroll
        for (int i = 0; i < 8; ++i) { const int idx = i * NTHREADS + tid, s = idx & 127, c8 = (idx >> 7) * 8; vq[i] = *(const GAS u32x4*)(UV + (tok0 + s) * UVP + GW + g * 256 + c8); }
#pragma unroll
        for (int i = 0; i < 8; ++i) { const int idx = i * NTHREADS + tid, s = idx & 127, c8 = (idx >> 7) * 8;
            const u32x4 v = vq[i];
            LAS bf16_t* d = vT + c8 * PITCH + s;
            d[0 * PITCH] = (bf16_t)(v.x & 0xffffu); d[1 * PITCH] = (bf16_t)(v.x >> 16); d[2 * PITCH] = (bf16_t)(v.y & 0xffffu); d[3 * PITCH] = (bf16_t)(v.y >> 16);
            d[4 * PITCH] = (bf16_t)(v.z & 0xffffu); d[5 * PITCH] = (bf16_t)(v.z >> 16); d[6 * PITCH] = (bf16_t)(v.w & 0xffffu); d[7 * PITCH] = (bf16_t)(v.w >> 16); }
        __syncthreads();
        f32x16 acc[4];
#pragma unroll
        for (int tb = 0; tb < 4; ++tb)
#pragma unroll
            for (int r = 0; r < 16; ++r) acc[tb][r] = 0.f;
#pragma unroll
        for (int ks = 0; ks < 8; ++ks) {
            const bf16x8 a = *(const LAS bf16x8*)(vT + (wave * 32 + ql) * PITCH + ks * 16 + hi * 8);
#pragma unroll
            for (int tb = 0; tb < 4; ++tb) if (2 * (tb + 1) > ks) {
                const bf16x8 bb = *(const LAS bf16x8*)(Wl + (tb * 32 + ql) * PITCH + ks * 16 + hi * 8);
                acc[tb] = __builtin_amdgcn_mfma_f32_32x32x16_bf16(a, bb, acc[tb], 0, 0, 0); }
        }
        __syncthreads();
        LAS float* Zs = (LAS float*)lds;
#pragma unroll
        for (int h = 0; h < 2; ++h) {
#pragma unroll
            for (int q = 0; q < 2; ++q) { const int tb = 2 * h + q, tl = q * 32 + ql;
                const float bbias = bsp[g * 128 + tb * 32 + ql];
                const GAS float* gp = gvn + g * 256 + wave * 32 + 4 * hi;
                f32x4 ggv[4];
#pragma unroll
                for (int rg = 0; rg < 4; ++rg) ggv[rg] = *(const GAS f32x4*)(gp + 8 * rg);
#pragma unroll
                for (int rg = 0; rg < 4; ++rg) { const f32x4 gg = ggv[rg];
                    f32x4 z; z.x = acc[tb][4 * rg + 0] * gg.x + bbias; z.y = acc[tb][4 * rg + 1] * gg.y + bbias; z.z = acc[tb][4 * rg + 2] * gg.z + bbias; z.w = acc[tb][4 * rg + 3] * gg.w + bbias;
                    *(LAS f32x4*)(Zs + tl * 260 + wave * 32 + 8 * rg + 4 * hi) = z; } }
            __syncthreads();
            u32x4 uq[4];
#pragma unroll
            for (int i = 0; i < 4; ++i) { const int p = i * NTHREADS + tid, t = p >> 5, c8 = (p & 31) * 8; uq[i] = *(const GAS u32x4*)(UV + (tok0 + 64 * h + t) * UVP + g * 256 + c8); }
#pragma unroll
            for (int i = 0; i < 4; ++i) { const int p = i * NTHREADS + tid, t = p >> 5, c8 = (p & 31) * 8;
                GAS bf16_t* up = UV + (tok0 + 64 * h + t) * UVP + g * 256 + c8;
                const u32x4 uu = uq[i];
                const LAS f32x4* zp = (const LAS f32x4*)(Zs + t * 260 + c8); const f32x4 z0 = zp[0], z1 = zp[1];
                u32x4 o; o.x = cvtpk(bflo(uu.x) * z0.x, bfhi(uu.x) * z0.y); o.y = cvtpk(bflo(uu.y) * z0.z, bfhi(uu.y) * z0.w);
                o.z = cvtpk(bflo(uu.z) * z1.x, bfhi(uu.z) * z1.y); o.w = cvtpk(bflo(uu.w) * z1.z, bfhi(uu.w) * z1.w);
                if (!dummy) *(GAS u32x4*)up = o; }
            __syncthreads();
        }
    }
}

DI void attn_unit(int bh, int qb, int nbh, int nqb, u32x4 (&qraw)[4], bf16x8 (&kf)[4], bf16x8 (&vl)[2][2], const GAS bf16_t* Qf, const GAS bf16_t* Kn, const GAS bf16_t* Vt, GAS bf16_t* O, LAS unsigned char* wl, int lane) {
    const int ql = lane & 31, hi = lane >> 5;
    const GAS bf16_t* kbase = Kn + (size_t)bh * (SEQ / 32) * 2048 + lane * 8;
    const GAS bf16_t* vbase = Vt + (size_t)bh * (SEQ / 32) * 2048 + lane * 8;
    bf16x8 kn[4], vn[2][2];
    { const int j1 = qb > 0 ? qb - 1 : 0;
#pragma unroll
      for (int d0 = 0; d0 < 4; ++d0) kn[d0] = *(const GAS bf16x8*)(kbase + (j1 * 4 + d0) * 512);
#pragma unroll
      for (int dh = 0; dh < 2; ++dh)
#pragma unroll
          for (int m = 0; m < 2; ++m) vn[dh][m] = *(const GAS bf16x8*)(vbase + (j1 * 4 + dh * 2 + m) * 512); }
    u32x4 qn[4]; bf16x8 kfn[4], vln[2][2];
#pragma unroll
    for (int d0 = 0; d0 < 4; ++d0) { qn[d0] = *(const GAS u32x4*)(Qf + ((size_t)(nbh * (SEQ / 32) + nqb) * 4 + d0) * 512 + lane * 8);
        kfn[d0] = *(const GAS bf16x8*)(Kn + ((size_t)(nbh * (SEQ / 32) + nqb) * 4 + d0) * 512 + lane * 8); }
#pragma unroll
    for (int dh = 0; dh < 2; ++dh)
#pragma unroll
        for (int m = 0; m < 2; ++m) vln[dh][m] = *(const GAS bf16x8*)(Vt + ((size_t)(nbh * (SEQ / 32) + nqb) * 4 + dh * 2 + m) * 512 + lane * 8);
    __builtin_amdgcn_sched_barrier(0);
    bf16x8 qr[4];
    {
        float ss = 0.f;
#pragma unroll
        for (int d0 = 0; d0 < 4; ++d0) {
            const float f0 = bflo(qraw[d0].x), f1 = bfhi(qraw[d0].x), f2 = bflo(qraw[d0].y), f3 = bfhi(qraw[d0].y), f4 = bflo(qraw[d0].z), f5 = bfhi(qraw[d0].z), f6 = bflo(qraw[d0].w), f7 = bfhi(qraw[d0].w);
            ss += (f0 * f0 + f1 * f1) + (f2 * f2 + f3 * f3) + (f4 * f4 + f5 * f5) + (f6 * f6 + f7 * f7); }
        ss += __shfl_xor(ss, 32);
        const float scl = rsqrtf(ss * (1.f / HD) + EPS) * (0.125f * LOG2E);
#pragma unroll
        for (int d0 = 0; d0 < 4; ++d0) { const LAS float* qg = (const LAS float*)(wl + 4608); const f32x4 g0 = *(const LAS f32x4*)(qg + d0 * 16 + hi * 8), g1 = *(const LAS f32x4*)(qg + d0 * 16 + hi * 8 + 4);
            u32x4 w; w.x = cvtpk(bflo(qraw[d0].x) * scl * g0.x, bfhi(qraw[d0].x) * scl * g0.y); w.y = cvtpk(bflo(qraw[d0].y) * scl * g0.z, bfhi(qraw[d0].y) * scl * g0.w);
            w.z = cvtpk(bflo(qraw[d0].z) * scl * g1.x, bfhi(qraw[d0].z) * scl * g1.y); w.w = cvtpk(bflo(qraw[d0].w) * scl * g1.z, bfhi(qraw[d0].w) * scl * g1.w);
            qr[d0] = __builtin_bit_cast(bf16x8, w); }
    }
    f32x16 o0, o1;
#pragma unroll
    for (int r = 0; r < 16; ++r) { o0[r] = 0.f; o1[r] = 0.f; }
    float carry = 0.f;
    for (int j = qb; j >= 0; --j) {
        f32x16 p;
#pragma unroll
        for (int r = 0; r < 16; ++r) p[r] = 0.f;
#pragma unroll
        for (int d0 = 0; d0 < 4; ++d0) p = __builtin_amdgcn_mfma_f32_32x32x16_bf16(kf[d0], qr[d0], p, 0, 0, 0);
        const int lim = (j == qb) ? ql : 64;
        float lk[16], lb[16];
#pragma unroll
        for (int r = 0; r < 16; ++r) { const float z = __builtin_amdgcn_fmed3f(p[r], -120.0f, 120.0f); const float sp = __builtin_amdgcn_logf(1.0f + __builtin_amdgcn_exp2f(z));
            const bool valid = ((r & 3) + 8 * (r >> 2) + 4 * hi) < lim;
            lk[r] = valid ? -sp : 0.f; lb[r] = valid ? (z - sp) : -1.0e30f; }
        float T[4], To[4], suf[16];
#pragma unroll
        for (int g = 0; g < 4; ++g) { suf[4 * g + 3] = 0.f; suf[4 * g + 2] = lk[4 * g + 3]; suf[4 * g + 1] = suf[4 * g + 2] + lk[4 * g + 2]; suf[4 * g] = suf[4 * g + 1] + lk[4 * g + 1]; T[g] = suf[4 * g] + lk[4 * g]; }
#pragma unroll
        for (int g = 0; g < 4; ++g) To[g] = __shfl_xor(T[g], 32);
        float run = carry, off[4];
#pragma unroll
        for (int g = 3; g >= 0; --g) { off[g] = run + (hi == 0 ? To[g] : 0.f); run += T[g] + To[g]; }
        float w[16];
#pragma unroll
        for (int r = 0; r < 16; ++r) w[r] = __builtin_amdgcn_exp2f(lb[r] + (off[r >> 2] + suf[r]));
        bf16x8 pf[2];
#pragma unroll
        for (int m = 0; m < 2; ++m) { u32x4 t; t.x = cvtpk(w[8 * m], w[8 * m + 1]); t.y = cvtpk(w[8 * m + 2], w[8 * m + 3]); t.z = cvtpk(w[8 * m + 4], w[8 * m + 5]); t.w = cvtpk(w[8 * m + 6], w[8 * m + 7]); pf[m] = __builtin_bit_cast(bf16x8, t); }
#pragma unroll
        for (int m = 0; m < 2; ++m) {
            o0 = __builtin_amdgcn_mfma_f32_32x32x16_bf16(vl[0][m], pf[m], o0, 0, 0, 0);
            o1 = __builtin_amdgcn_mfma_f32_32x32x16_bf16(vl[1][m], pf[m], o1, 0, 0, 0);
        }
        carry = run;
        if (__builtin_amdgcn_ballot_w64(carry >= CARRY_STOP) == 0ull) break;
        __builtin_amdgcn_sched_barrier(0);
        asm volatile("" : "+v"(kn[0]), "+v"(kn[1]), "+v"(kn[2]), "+v"(kn[3]));
        asm volatile("" : "+v"(vn[0][0]), "+v"(vn[0][1]), "+v"(vn[1][0]), "+v"(vn[1][1]));
#pragma unroll
        for (int d0 = 0; d0 < 4; ++d0) kf[d0] = kn[d0];
#pragma unroll
        for (int dh = 0; dh < 2; ++dh)
#pragma unroll
            for (int m = 0; m < 2; ++m) vl[dh][m] = vn[dh][m];
        { const int j2 = j > 2 ? j - 2 : 0;
#pragma unroll
          for (int d0 = 0; d0 < 4; ++d0) kn[d0] = *(const GAS bf16x8*)(kbase + (j2 * 4 + d0) * 512);
#pragma unroll
          for (int dh = 0; dh < 2; ++dh)
#pragma unroll
              for (int m = 0; m < 2; ++m) vn[dh][m] = *(const GAS bf16x8*)(vbase + (j2 * 4 + dh * 2 + m) * 512); }
        __builtin_amdgcn_sched_barrier(0);
    }
    {
        LAS bf16_t* tl = (LAS bf16_t*)wl;
#pragma unroll
        for (int g = 0; g < 4; ++g) {
            u32x2 w0; w0.x = cvtpk(o0[4 * g], o0[4 * g + 1]); w0.y = cvtpk(o0[4 * g + 2], o0[4 * g + 3]); *(LAS u32x2*)(tl + ql * 72 + 8 * g + 4 * hi) = w0;
            u32x2 w1; w1.x = cvtpk(o1[4 * g], o1[4 * g + 1]); w1.y = cvtpk(o1[4 * g + 2], o1[4 * g + 3]); *(LAS u32x2*)(tl + ql * 72 + 32 + 8 * g + 4 * hi) = w1;
        }
        asm volatile("s_waitcnt lgkmcnt(0)" ::: "memory");
        GAS bf16_t* op = O + ((size_t)(bh >> 4) * SEQ + (size_t)qb * 32) * DM + (bh & 15) * HD;
#pragma unroll
        for (int i = 0; i < 4; ++i) { const int row = i * 8 + (lane >> 3), ch = lane & 7; const u32x4 v = *(const LAS u32x4*)(tl + row * 72 + ch * 8); *(GAS u32x4*)(op + (size_t)row * DM + ch * 8) = v; }
        asm volatile("s_waitcnt lgkmcnt(0)" ::: "memory");
    }
    __builtin_amdgcn_sched_barrier(0);
    asm volatile("" : "+v"(qn[0]), "+v"(qn[1]), "+v"(qn[2]), "+v"(qn[3]));
    asm volatile("" : "+v"(kfn[0]), "+v"(kfn[1]), "+v"(kfn[2]), "+v"(kfn[3]));
    asm volatile("" : "+v"(vln[0][0]), "+v"(vln[0][1]), "+v"(vln[1][0]), "+v"(vln[1][1]));
#pragma unroll
    for (int d0 = 0; d0 < 4; ++d0) { qraw[d0] = qn[d0]; kf[d0] = kfn[d0]; }
#pragma unroll
    for (int dh = 0; dh < 2; ++dh)
#pragma unroll
        for (int m = 0; m < 2; ++m) vl[dh][m] = vln[dh][m];
}
DI void attn_phase(LAS unsigned char* lds, const bf16_t* Qf_, const bf16_t* Kn_, const bf16_t* Vt_, bf16_t* O_, const float* qg_, int wave, int lane, int G, int vcu) {
    const GAS bf16_t* Qf = (const GAS bf16_t*)Qf_; const GAS bf16_t* Kn = (const GAS bf16_t*)Kn_; const GAS bf16_t* Vt = (const GAS bf16_t*)Vt_;
    const int gw = vcu * 8 + wave, NGW = G * 8, NU = BATCH * NH * (SEQ / 32);
    LAS unsigned char* wl = lds + wave * 8192;
    ((LAS float*)(wl + 4608))[lane] = ((const GAS float*)qg_)[lane];
    asm volatile("s_waitcnt vmcnt(0) lgkmcnt(0)" ::: "memory");
    int u = gw; if (u >= NU) return;
#if ATTN_SKEW
    if (wave >= 4) __builtin_amdgcn_s_sleep(ATTN_SKEW);
#endif
    u32x4 qraw[4]; bf16x8 kf[4], vl[2][2];
#pragma unroll
    for (int d0 = 0; d0 < 4; ++d0) { qraw[d0] = *(const GAS u32x4*)(Qf + ((size_t)u * 4 + d0) * 512 + lane * 8); kf[d0] = *(const GAS bf16x8*)(Kn + ((size_t)u * 4 + d0) * 512 + lane * 8); }
#pragma unroll
    for (int dh = 0; dh < 2; ++dh)
#pragma unroll
        for (int m = 0; m < 2; ++m) vl[dh][m] = *(const GAS bf16x8*)(Vt + ((size_t)u * 4 + dh * 2 + m) * 512 + lane * 8);
    for (; u < NU; u += NGW) { const int un = (u + NGW < NU) ? u + NGW : u;
        attn_unit(u >> 7, u & 127, un >> 7, un & 127, qraw, kf, vl, Qf, Kn, Vt, (GAS bf16_t*)O_, wl, lane); }
}

#define XB_TMO      128
#define XB_XCNT(j)  (256  + 64 * (j))
#define XB_XSUB(j)  (1280 + 64 * (j))
#define XB_XGEN(j)  (2304 + 64 * (j))
#define XB_TOP      3328
#define XB_TOPGEN   3392
#define XCD_BAR_WORDS 3456
#define XB_SPIN_CAP (1u << 20)
DI unsigned xb_ld(unsigned* p)              { return __hip_atomic_load(p, __ATOMIC_RELAXED, __HIP_MEMORY_SCOPE_AGENT); }
DI unsigned xb_add(unsigned* p, unsigned v) { return __hip_atomic_fetch_add(p, v, __ATOMIC_RELAXED, __HIP_MEMORY_SCOPE_AGENT); }
DI unsigned xb_xcc_id() { return (unsigned)__builtin_amdgcn_s_getreg((3 << 11) | 20) & 0xFu; }
#define XB_SPIN(cond, bar) do { unsigned _sp = 0; while (cond) { __builtin_amdgcn_s_sleep(1); \
    if ((++_sp & 255u) == 0u) { if (xb_ld(&(bar)[XB_TMO])) break; if (_sp > XB_SPIN_CAP) { atomicAdd(&(bar)[XB_TMO], 1u); break; } } } } while (0)
struct XcdBarrier { unsigned* bar; unsigned x; volatile LAS unsigned* st; };
DI void xcd_barrier_complete(unsigned* bar, unsigned x, unsigned& nloc, unsigned& nx) {
    const unsigned G = gridDim.x * gridDim.y * gridDim.z;
    unsigned sum, cnt, mine, sp = 0u;
    for (;;) {
        sum = 0u; cnt = 0u; mine = 0u;
#pragma unroll
        for (unsigned j = 0; j < 16; ++j) { const unsigned c = xb_ld(&bar[XB_XCNT(j)]); sum += c; cnt += (c > 0u) ? 1u : 0u; mine = (j == x) ? c : mine; }
        if (sum == G) break;
        __builtin_amdgcn_s_sleep(1);
        if ((++sp & 255u) == 0u) { if (xb_ld(&bar[XB_TMO])) break; if (sp > XB_SPIN_CAP) { atomicAdd(&bar[XB_TMO], 1u); break; } }
    }
    nloc = mine > 0u ? mine : 1u; nx = cnt > 0u ? cnt : 1u;
}
DI void xcd_barrier(const XcdBarrier& b) {
    asm volatile("s_waitcnt vmcnt(0)" ::: "memory");
    __syncthreads();
    if (threadIdx.x == 0) {
        unsigned* bar = b.bar;
        __builtin_amdgcn_s_waitcnt(0);
        unsigned nloc = b.st[0], nx = b.st[1];
        if (nloc == 0u) { xcd_barrier_complete(bar, b.x, nloc, nx); b.st[0] = nloc; b.st[1] = nx; }
        const unsigned old = xb_add(&bar[XB_XSUB(b.x)], 1u);
        const unsigned gen = old / nloc;
        if (old + 1u == (gen + 1u) * nloc) {
            __builtin_amdgcn_fence(__ATOMIC_RELEASE, "agent");
            asm volatile("s_waitcnt vmcnt(0)" ::: "memory");
            const unsigned og = xb_add(&bar[XB_TOP], 1u);
            const unsigned tg = og / nx;
            if (og + 1u == (tg + 1u) * nx) xb_add(&bar[XB_TOPGEN], 1u);
            else XB_SPIN(xb_ld(&bar[XB_TOPGEN]) == tg, bar);
            __builtin_amdgcn_fence(__ATOMIC_ACQUIRE, "agent");
            xb_add(&bar[XB_XGEN(b.x)], 1u);
            asm volatile("s_waitcnt vmcnt(0)" ::: "memory");
        } else {
            XB_SPIN(xb_ld(&bar[XB_XGEN(b.x)]) == gen, bar);
            __builtin_amdgcn_fence(__ATOMIC_ACQUIRE, "agent");
            asm volatile("s_waitcnt vmcnt(0)" ::: "memory");
        }
    }
    __syncthreads();
}

enum { PI_X = 0, PI_C, PI_MODW, PI_MODB, PI_NORMG, PI_WUP, PI_WDN, PI_AWIN, PI_AVG, PI_AWS, PI_ABS, PI_AWOUT, PI_KVMODW, PI_KVMODB, PI_KVNORMG, PI_KVW, PI_KNORMG, PI_BWQ, PI_QNORMG, PI_BWOUT, PI_OUT, PI_WS, PI_N };
constexpr int PTAB_OFF = LDS_BYTES - 512, XBST_OFF = LDS_BYTES - 64;
template <class T> DI T* ldp(int i) {
    extern __shared__ __attribute__((aligned(16))) unsigned char lds_raw[];
    const LAS unsigned* t = (const LAS unsigned*)((LAS unsigned char*)lds_raw + PTAB_OFF) + 2 * i;
    const unsigned lo = __builtin_amdgcn_readfirstlane(t[0]), hi = __builtin_amdgcn_readfirstlane(t[1]);
    return (T*)(((unsigned long long)hi << 32) | (unsigned long long)lo);
}
__global__ void __launch_bounds__(NTHREADS, 2) yoco_fwd(Params p) {
    extern __shared__ __attribute__((aligned(16))) unsigned char lds_raw[];
    LAS unsigned char* lds = (LAS unsigned char*)lds_raw;
    cg::grid_group grid = cg::this_grid();
    using pg8::Gemm; using pg8::StaticOrder; using pg8::EpiAct; using pg8::EpiRes; using pg8::gemm_phase;
    {
        LAS unsigned long long* pt = (LAS unsigned long long*)(lds + PTAB_OFF);
        if (threadIdx.x < 2) ((LAS unsigned*)(lds + XBST_OFF))[threadIdx.x] = 0u;
        if (threadIdx.x == 0) (void)xb_add((unsigned*)p.ws + XB_XCNT(xb_xcc_id()), 1u);
        if (threadIdx.x == 0) {
            const float* const* src = (const float* const*)&p;
#pragma unroll
            for (int i = 0; i < PI_N; ++i) pt[i] = (unsigned long long)src[i];
        }
        __syncthreads();
        const int tid = threadIdx.x, lane = tid & 63, wave = __builtin_amdgcn_readfirstlane(tid >> 6);
        Params q;
        q.x = ldp<const float>(PI_X); q.c = ldp<const float>(PI_C); q.mod_w = ldp<const float>(PI_MODW); q.mod_b = ldp<const float>(PI_MODB); q.norm_g = nullptr;
        q.w_up = ldp<const float>(PI_WUP); q.w_down = ldp<const float>(PI_WDN); q.a_w_in = ldp<const float>(PI_AWIN); q.a_vg = nullptr; q.a_ws = nullptr; q.a_bs = nullptr;
        q.a_w_out = ldp<const float>(PI_AWOUT); q.kv_mod_w = ldp<const float>(PI_KVMODW); q.kv_mod_b = ldp<const float>(PI_KVMODB); q.kv_norm_g = nullptr; q.kv_w = ldp<const float>(PI_KVW);
        q.k_norm_g = nullptr; q.b_w_q = ldp<const float>(PI_BWQ); q.q_norm_g = nullptr; q.b_w_out = ldp<const float>(PI_BWOUT); q.out = nullptr; q.ws = ldp<unsigned char>(PI_WS);
        for (int rep = 0; rep < REP_P0; ++rep) { p0_phase(q, lds, tid, wave, lane, gridDim.x, blockIdx.x); __syncthreads(); }
    }
    if (gridDim.x == 0x7fffffffu) grid.sync();
    { XcdBarrier xb; xb.bar = (unsigned*)ldp<unsigned char>(PI_WS); xb.x = xb_xcc_id(); xb.st = (volatile LAS unsigned*)(lds + XBST_OFF); xcd_barrier(xb); }

    for (int layer = 0; layer < 4; ++layer) {
        for (int step = 0; step < 12; ++step) {
            if (step >= 9 && layer != 1) break;
            if (step == 7 || step == 8 || step == 11) continue;
            if (step == 0 && layer == 2) continue;
            int tid = threadIdx.x; asm volatile("" : "+v"(tid));
            const int lane = tid & 63, wave = __builtin_amdgcn_readfirstlane(tid >> 6);
            int bid = blockIdx.x; asm volatile("" : "+s"(bid));
            const int G = gridDim.x;
            unsigned char* ws = ldp<unsigned char>(PI_WS);
            float* outp = ldp<float>(PI_OUT);
            const float* xcur = (layer == 0 && step <= 3) ? ldp<const float>(PI_X) : outp;
            float* MOD = (float*)(ws + WS_MOD);
            const float* modl = MOD + (size_t)layer * 8 * MODS;
            bf16_t* XN = (bf16_t*)(ws + WS_XN);
            const bool lo = layer < 2; const int j = layer & 1;
            if (step == 0 || step == 4 || step == 9) {
                const float* gn = step == 9 ? ldp<const float>(PI_KVNORMG) : ldp<const float>(PI_NORMG) + (layer * 2 + (step == 4 ? 1 : 0)) * DM;
                const float* mv = step == 9 ? MOD + (size_t)4 * 8 * MODS : modl + (step == 4 ? 3 * DM : 0);
                for (int rep = 0; rep < REP_NORM; ++rep)
                if (step == 0 && layer == 2 && rep == 0) norm_phase<true>(xcur, gn, mv, mv + DM, XN, nullptr, nullptr, nullptr, nullptr, true, (const bf16_t*)(ws + WS_KR), ldp<const float>(PI_KNORMG), (bf16_t*)(ws + WS_KF), (const bf16_t*)(ws + WS_VT), (bf16_t*)(ws + WS_VF), wave, lane, G, bid);
                else if (step == 9) norm_phase<false>(xcur, gn, mv, mv + DM, XN, ldp<const float>(PI_NORMG) + 4 * DM, MOD + (size_t)2 * 8 * MODS, MOD + (size_t)2 * 8 * MODS + DM, (bf16_t*)(ws + WS_XN2), false, nullptr, nullptr, nullptr, nullptr, nullptr, wave, lane, G, bid);
                else norm_phase<false>(xcur, gn, mv, mv + DM, XN, nullptr, nullptr, nullptr, nullptr, false, nullptr, nullptr, nullptr, nullptr, nullptr, wave, lane, G, bid);
            } else if (step == 1 || step == 5 || step == 10) {
                Gemm g; EpiAct E;
                if (step == 1) {
                    if (lo) { g = Gemm{XN, (const bf16_t*)(ws + WS_WIN) + (size_t)j * DM * 2 * GW, MTOK, 2 * GW, DM, DM, DM}; E = EpiAct{(bf16_t*)(ws + WS_UV), UVP, 1, (float*)(ws + WS_SSQ), 8, 0}; }
                    else    { g = Gemm{layer == 2 ? (const bf16_t*)(ws + WS_XN2) : (const bf16_t*)XN, (const bf16_t*)(ws + WS_WQ) + (size_t)j * DM * DM, MTOK, DM, DM, DM, DM}; E = EpiAct{(bf16_t*)(ws + WS_Q), DM, 0, nullptr, 0, 1}; }
                } else if (step == 5) {
                    g = Gemm{XN, (const bf16_t*)(ws + ws_up(layer)), MTOK, DFF, DM, DM, DM}; E = EpiAct{(bf16_t*)(ws + WS_H), HP, 2, nullptr, 0, 0};
                }
                const int nparts = (step == 10) ? 2 : 1;
                for (int part = 0; part < nparts; ++part) {
                if (step == 10) {
                    if (part == 0) { g = Gemm{XN, (const bf16_t*)(ws + WS_WKV), MTOK, DM, DM, DM, DM}; E = EpiAct{(bf16_t*)(ws + WS_KF), DM, 0, nullptr, 0, 1}; }
                    else { g = Gemm{(const bf16_t*)(ws + WS_WKV) + (size_t)DM * DM, XN, DM, MTOK, DM, DM, DM}; E = EpiAct{(bf16_t*)(ws + WS_VF), VTP, 0, nullptr, 0, 2}; }
                }
                StaticOrder S; S.init(g.M, g.N, G, bid);
#if STAGGER
                if (g.N >= 4096) { const int dly = ((bid >> 3) & 3) * STAGGER; for (int q = 0; q < dly; ++q) __builtin_amdgcn_s_sleep(127); }
#endif
                const int nrep = (step == 1 && lo) ? REP_G1 : (step == 5 ? REP_UP : REP_GACT);
                for (int rep = 0; rep < nrep; ++rep) gemm_phase<EpiAct, StaticOrder, true, true>(lds, g, S, E, tid);
                if (step == 10 && part == 0) { asm volatile("s_waitcnt vmcnt(0)" ::: "memory"); __syncthreads(); knorm_own_units((bf16_t*)(ws + WS_KF), ldp<const float>(PI_KNORMG), S, wave, lane); }
                }
            } else if (step == 3 || step == 6) {
                Gemm g; EpiRes E;
                if (step == 3) {
                    if (lo) g = Gemm{(const bf16_t*)(ws + WS_UV), (const bf16_t*)(ws + WS_WAO) + (size_t)j * GW * DM, MTOK, DM, GW, UVP, GW};
                    else    g = Gemm{(const bf16_t*)(ws + WS_O), (const bf16_t*)(ws + WS_WBO) + (size_t)j * DM * DM, MTOK, DM, DM, DM, DM};
                    E = EpiRes{xcur, outp, modl + 2 * DM, 0};
                } else {
                    g = Gemm{(const bf16_t*)(ws + WS_H), (const bf16_t*)(ws + ws_dn(layer)), MTOK, DM, DFF, HP, DFF}; E = EpiRes{xcur, outp, modl + 5 * DM, 0};
                }
                StaticOrder S; S.init(g.M, g.N, G, bid);
                gemm_phase<EpiRes, StaticOrder, true, true>(lds, g, S, E, tid);
            } else {
                if (lo) for (int rep = 0; rep < REP_SPAT; ++rep) spatial_phase(lds, (bf16_t*)(ws + WS_UV), (const float*)(ws + WS_SSQ), ldp<const float>(PI_AWS) + (size_t)j * 8 * 128 * 128, ldp<const float>(PI_ABS) + j * 8 * 128, ldp<const float>(PI_AVG) + j * GW, tid, wave, lane, G, bid, rep + 1 < REP_SPAT);
                else { const int vcu = (G % 8 == 0) ? (bid % 8) * (G / 8) + bid / 8 : bid;
                       for (int rep = 0; rep < REP_ATTN; ++rep) attn_phase(lds, (const bf16_t*)(ws + WS_Q), (const bf16_t*)(ws + WS_KF), (const bf16_t*)(ws + WS_VF), (bf16_t*)(ws + WS_O), ldp<const float>(PI_QNORMG) + j * HD, wave, lane, G, vcu); }
            }
            { XcdBarrier xb; xb.bar = (unsigned*)ldp<unsigned char>(PI_WS); xb.x = xb_xcc_id(); xb.st = (volatile LAS unsigned*)(lds + XBST_OFF);
              for (int rep = 0; rep < REP_SYNC; ++rep) xcd_barrier(xb); }
        }
    }
}

extern "C" void kernel_launch(void* const* d_in, const int* in_sizes, int n_in, void* d_out, int out_size, void* d_ws, size_t ws_size, hipStream_t stream) {
    static int grid = 0;
    if (grid == 0) {
        if (n_in != 20 || ws_size < WS_END) { fprintf(stderr, "kernel_launch: unexpected n_in %d / ws_size %zu\n", n_in, ws_size); grid = -1; return; }
        int dev = 0, cus = 0, per_cu = 0;
        (void)hipGetDevice(&dev);
        (void)hipDeviceGetAttribute(&cus, hipDeviceAttributeMultiprocessorCount, dev);
        if (hipFuncSetAttribute((const void*)yoco_fwd, hipFuncAttributeMaxDynamicSharedMemorySize, LDS_BYTES) != hipSuccess) { fprintf(stderr, "kernel_launch: hipFuncSetAttribute failed\n"); }
        if (hipOccupancyMaxActiveBlocksPerMultiprocessor(&per_cu, (const void*)yoco_fwd, NTHREADS, LDS_BYTES) != hipSuccess || per_cu < 1) { fprintf(stderr, "kernel_launch: occupancy query says %d\n", per_cu); per_cu = 1; }
        (void)hipGetLastError();
        grid = cus > 0 ? cus : 256;
    }
    if (grid < 0) return;
    if (hipMemsetAsync(d_ws, 0, 16384, stream) != hipSuccess) { fprintf(stderr, "kernel_launch: hipMemsetAsync failed\n"); return; }
    Params p{};
    const float** pp = (const float**)&p;
    for (int i = 0; i < 20; ++i) pp[i] = (const float*)d_in[i];
    p.out = (float*)d_out; p.ws = (unsigned char*)d_ws;
    void* args[] = {&p};
    hipError_t e = hipLaunchCooperativeKernel((const void*)yoco_fwd, dim3(grid), dim3(NTHREADS), args, LDS_BYTES, stream);
    if (e != hipSuccess) fprintf(stderr, "kernel_launch: cooperative launch failed: %s (grid %d)\n", hipGetErrorString(e), grid);
}
```
